# Optimizing an MI355X kernel written in HIP

```python
import jax, jax.numpy as jnp
from jax import lax
import numpy as np


D_MODEL = 2048
BATCH = 4
SEQ = 4096
DEPTH = 1

M_HEADS = 4
M_WIDTH = D_MODEL // 2
M_HEAD_DIM = M_WIDTH // M_HEADS
M_CHUNK = 128
CONV_WIDTH = 4
G_WIDTH = D_MODEL // 2
G_GROUPS = 8
G_GROUP_DIM = G_WIDTH // G_GROUPS
G_CHUNK = 128
N_GROUPS = 4
EXPERTS_PER_GROUP = 8
N_EXPERTS = N_GROUPS * EXPERTS_PER_GROUP
TOP_K = 2
D_EXPERT = 512
MOE_BLOCK = 128
PLE_DIM = 256
N_BRANCHES = 2
EPS = 1e-6
IN_COLS = 4 * M_WIDTH + 2 * M_HEADS + 2 * G_WIDTH + N_BRANCHES * D_MODEL

kernel_name = 'hybrid_mlstm_gmlp_hmoe_block'


def rms_norm(x, g):
    xf = x.astype(jnp.float32)
    y = xf * lax.rsqrt(jnp.mean(xf * xf, axis=-1, keepdims=True) + EPS)
    return (y * g.astype(jnp.float32)).astype(x.dtype)


def causal_conv(x, w, b):
    K, C = w.shape
    y = lax.conv_general_dilated(x, w[:, None, :].astype(x.dtype), window_strides=(1,),
                                 padding=[(K - 1, 0)], dimension_numbers=('NWC', 'WIO', 'NWC'),
                                 feature_group_count=C)
    return y + b


def mlstm_chunkwise(q, k, v, i_pre, f_pre):
    B, S, H, Dh = q.shape
    L = M_CHUNK
    NC = S // L
    f32 = jnp.float32

    def chunk(t):
        t = t.astype(f32).reshape((B, NC, L, H) + t.shape[3:])
        return jnp.moveaxis(t, 3, 1)

    q = chunk(q)
    k = chunk(k) * (Dh ** -0.5)
    v = chunk(v)
    ig = chunk(i_pre)
    lf = jax.nn.log_sigmoid(chunk(f_pre))
    b = jnp.cumsum(lf, axis=-1)
    g = b[..., -1]

    a = g[..., None] - b + ig
    m_loc = jnp.max(a, axis=-1)
    w_loc = jnp.exp(a - m_loc[..., None])
    kv_loc = jnp.einsum('bhcl,bhcld,bhcle->bhcde', w_loc, k, v)
    n_loc = jnp.einsum('bhcl,bhcld->bhcd', w_loc, k)

    def step(carry, xs):
        C, n, m = carry
        kv_c, n_c, m_c, g_c = xs
        m_new = jnp.maximum(g_c + m, m_c)
        s_old = jnp.exp(g_c + m - m_new)
        s_loc = jnp.exp(m_c - m_new)
        C_new = s_old[..., None, None] * C + s_loc[..., None, None] * kv_c
        n_new = s_old[..., None] * n + s_loc[..., None] * n_c
        return (C_new, n_new, m_new), (C, n, m)

    init = (jnp.zeros((B, H, Dh, Dh), f32), jnp.zeros((B, H, Dh), f32), jnp.zeros((B, H), f32))
    xs = (jnp.moveaxis(kv_loc, 2, 0), jnp.moveaxis(n_loc, 2, 0),
          jnp.moveaxis(m_loc, 2, 0), jnp.moveaxis(g, 2, 0))
    _, (C_prev, n_prev, m_prev) = lax.scan(step, init, xs)
    C_prev = jnp.moveaxis(C_prev, 0, 2)
    n_prev = jnp.moveaxis(n_prev, 0, 2)
    m_prev = jnp.moveaxis(m_prev, 0, 2)

    log_d = b[..., :, None] - b[..., None, :] + ig[..., None, :]
    causal = jnp.tril(jnp.ones((L, L), dtype=bool))
    log_d = jnp.where(causal, log_d, -jnp.inf)
    log_inter = b + m_prev[..., None]
    m = jnp.maximum(log_inter, jnp.max(log_d, axis=-1))
    d = jnp.exp(log_d - m[..., None])
    s_inter = jnp.exp(log_inter - m)
    qk = jnp.einsum('bhcld,bhcsd->bhcls', q, k) * d
    num = (jnp.einsum('bhcls,bhcse->bhcle', qk, v)
           + s_inter[..., None] * jnp.einsum('bhcld,bhcde->bhcle', q, C_prev))
    den = jnp.sum(qk, axis=-1) + s_inter * jnp.einsum('bhcld,bhcd->bhcl', q, n_prev)
    h = num / jnp.maximum(jnp.abs(den), jnp.exp(-m))[..., None]
    return jnp.moveaxis(h, 1, 3).reshape(B, S, H, Dh)


def head_norm(h, g):
    B, S, H, Dh = h.shape
    mu = jnp.mean(h, axis=-1, keepdims=True)
    var = jnp.mean(jnp.square(h - mu), axis=-1, keepdims=True)
    return ((h - mu) * lax.rsqrt(var + EPS)).reshape(B, S, H * Dh) * g.astype(jnp.float32)


def spatial_gating(u, v, ln_g, ln_b, w_s, b_s):
    B, S, _ = v.shape
    NCk = S // G_CHUNK
    vf = v.astype(jnp.float32)
    mu = jnp.mean(vf, axis=-1, keepdims=True)
    var = jnp.mean(jnp.square(vf - mu), axis=-1, keepdims=True)
    vn = (vf - mu) * lax.rsqrt(var + EPS) * ln_g.astype(jnp.float32) + ln_b.astype(jnp.float32)
    vn = vn.reshape(B, NCk, G_CHUNK, G_GROUPS, G_GROUP_DIM)
    causal = jnp.tril(jnp.ones((G_CHUNK, G_CHUNK), dtype=bool))
    w = jnp.where(causal, w_s.astype(jnp.float32), 0.0)
    mixed = (jnp.einsum('gts,bcsge->bctge', w, vn)
             + jnp.transpose(b_s.astype(jnp.float32))[None, None, :, :, None])
    return u * mixed.reshape(B, S, G_WIDTH).astype(u.dtype)


def token_mixers(hn, w_in, conv_w, conv_b, b_gate, gn_m, ln_g, ln_b, w_s, b_s, w_bm, w_bg, w_out):
    B, S, _ = hn.shape
    proj = hn @ w_in
    sizes = (M_WIDTH, M_WIDTH, M_WIDTH, M_WIDTH, 2 * M_HEADS, G_WIDTH, G_WIDTH)
    cuts = [int(c) for c in np.cumsum(sizes)]
    q, k, v, o_pre, if_pre, u, vg, gates = jnp.split(proj, cuts, axis=-1)
    qk = jax.nn.silu(causal_conv(jnp.concatenate([q, k], axis=-1), conv_w, conv_b))
    q, k = jnp.split(qk, 2, axis=-1)
    heads = lambda t: t.reshape(B, S, M_HEADS, M_HEAD_DIM)
    gate_pre = if_pre.astype(jnp.float32) + b_gate.astype(jnp.float32)
    h = mlstm_chunkwise(heads(q), heads(k), heads(v), gate_pre[..., :M_HEADS], gate_pre[..., M_HEADS:])
    h_m = (jax.nn.sigmoid(o_pre.astype(jnp.float32)) * head_norm(h, gn_m)).astype(hn.dtype)
    h_g = spatial_gating(jax.nn.gelu(u), jax.nn.gelu(vg), ln_g, ln_b, w_s, b_s)
    g_m, g_g = jnp.split(jax.nn.sigmoid(gates), 2, axis=-1)
    merged = g_m * (h_m @ w_bm) + g_g * (h_g @ w_bg)
    return merged @ w_out


def hier_moe(h, w_rg, b_rg, w_re, b_re, w1, w3, w2):
    B, S, D = h.shape
    T = B * S
    f32 = jnp.float32
    hf = h.reshape(T, D)
    g_logits = (hf @ w_rg).astype(f32) + b_rg.astype(f32)
    g_prob = jax.nn.softmax(g_logits, axis=-1)
    grp = jnp.argmax(g_logits, axis=-1)
    p_grp = jnp.take_along_axis(g_prob, grp[:, None], axis=-1)
    e_logits = ((hf @ w_re).astype(f32) + b_re.astype(f32)).reshape(T, N_GROUPS, EXPERTS_PER_GROUP)
    e_logits = jnp.take_along_axis(e_logits, grp[:, None, None], axis=1)[:, 0]
    top_v, top_i = lax.top_k(e_logits, TOP_K)
    wts = jax.nn.softmax(top_v, axis=-1) * p_grp
    eid = grp[:, None] * EXPERTS_PER_GROUP + top_i

    A = T * TOP_K
    flat_e = eid.reshape(A)
    flat_w = wts.reshape(A)
    flat_t = jnp.repeat(jnp.arange(T, dtype=jnp.int32), TOP_K)
    order = jnp.argsort(flat_e)
    se, st, sw = flat_e[order], flat_t[order], flat_w[order]
    counts = jnp.bincount(flat_e, length=N_EXPERTS)
    starts = jnp.cumsum(counts) - counts
    padded = (counts + MOE_BLOCK - 1) // MOE_BLOCK * MOE_BLOCK
    pends = jnp.cumsum(padded)
    pstarts = pends - padded
    dest = pstarts[se] + jnp.arange(A) - starts[se]
    NB = -(-A // MOE_BLOCK) + N_EXPERTS
    P = NB * MOE_BLOCK
    tok_buf = jnp.full((P,), T, dtype=jnp.int32).at[dest].set(st)
    w_buf = jnp.zeros((P,), f32).at[dest].set(sw)
    blk_e = jnp.clip(jnp.searchsorted(pends, jnp.arange(NB) * MOE_BLOCK, side='right'), 0, N_EXPERTS - 1)

    h_pad = jnp.concatenate([hf, jnp.zeros((1, D), hf.dtype)], axis=0)
    xb = h_pad[tok_buf].reshape(NB, MOE_BLOCK, D)

    def expert_block(args):
        xblk, e = args
        return (jax.nn.silu(xblk @ w1[e]) * (xblk @ w3[e])) @ w2[e]

    yb = lax.map(expert_block, (xb, blk_e)).reshape(P, D)
    out = jnp.zeros((T + 1, D), f32).at[tok_buf].add(yb.astype(f32) * w_buf[:, None])[:T]
    return out.reshape(B, S, D).astype(h.dtype)


def setup_inputs(seed: int = 0) -> dict:
    key = jax.random.key(seed)
    ks = jax.random.split(key, 32)
    f32 = jnp.float32
    nrm = lambda k, shape, scale: jax.random.normal(k, shape, f32) * scale
    L = DEPTH
    x = nrm(ks[0], (BATCH, SEQ, D_MODEL), 1.0)
    p = nrm(ks[1], (DEPTH, BATCH, SEQ, PLE_DIM), 1.0)
    g_mix = 1.0 + nrm(ks[2], (L, D_MODEL), 0.02)
    w_in = nrm(ks[3], (L, D_MODEL, IN_COLS), D_MODEL ** -0.5)
    conv_w = nrm(ks[4], (L, CONV_WIDTH, 2 * M_WIDTH), CONV_WIDTH ** -0.5)
    conv_b = nrm(ks[5], (L, 2 * M_WIDTH), 0.02)
    b_i = nrm(ks[6], (L, M_HEADS), 0.1)
    b_f = jnp.linspace(3.0, 6.0, M_HEADS, dtype=f32)[None, :] + nrm(ks[7], (L, M_HEADS), 0.1)
    b_gate = jnp.concatenate([b_i, b_f], axis=-1)
    gn_m = 1.0 + nrm(ks[8], (L, M_WIDTH), 0.02)
    ln_g = 1.0 + nrm(ks[9], (L, G_WIDTH), 0.02)
    ln_b = nrm(ks[10], (L, G_WIDTH), 0.02)
    w_s = nrm(ks[11], (L, G_GROUPS, G_CHUNK, G_CHUNK), G_CHUNK ** -0.5)
    b_s = 1.0 + nrm(ks[12], (L, G_GROUPS, G_CHUNK), 0.02)
    w_bm = nrm(ks[13], (L, M_WIDTH, D_MODEL), M_WIDTH ** -0.5)
    w_bg = nrm(ks[14], (L, G_WIDTH, D_MODEL), G_WIDTH ** -0.5)
    w_out = nrm(ks[15], (L, D_MODEL, D_MODEL), D_MODEL ** -0.5)
    g_ffn = 1.0 + nrm(ks[16], (L, D_MODEL), 0.02)
    w_rg = nrm(ks[17], (L, D_MODEL, N_GROUPS), D_MODEL ** -0.5)
    b_rg = nrm(ks[18], (L, N_GROUPS), 0.01)
    w_re = nrm(ks[19], (L, D_MODEL, N_EXPERTS), D_MODEL ** -0.5)
    b_re = nrm(ks[20], (L, N_EXPERTS), 0.01)
    w1 = nrm(ks[21], (L, N_EXPERTS, D_MODEL, D_EXPERT), D_MODEL ** -0.5)
    w3 = nrm(ks[22], (L, N_EXPERTS, D_MODEL, D_EXPERT), D_MODEL ** -0.5)
    w2 = nrm(ks[23], (L, N_EXPERTS, D_EXPERT, D_MODEL), D_EXPERT ** -0.5)
    g_ple = 1.0 + nrm(ks[24], (L, D_MODEL), 0.02)
    w_ple_up = nrm(ks[25], (L, PLE_DIM, D_MODEL), PLE_DIM ** -0.5)
    w_ple_gate = nrm(ks[26], (L, D_MODEL, D_MODEL), D_MODEL ** -0.5)
    g_final = 1.0 + nrm(ks[27], (D_MODEL,), 0.02)
    return {'x': x, 'p': p, 'g_mix': g_mix, 'w_in': w_in, 'conv_w': conv_w, 'conv_b': conv_b,
            'b_gate': b_gate, 'gn_m': gn_m, 'ln_g': ln_g, 'ln_b': ln_b, 'w_s': w_s, 'b_s': b_s,
            'w_bm': w_bm, 'w_bg': w_bg, 'w_out': w_out, 'g_ffn': g_ffn, 'w_rg': w_rg, 'b_rg': b_rg,
            'w_re': w_re, 'b_re': b_re, 'w1': w1, 'w3': w3, 'w2': w2, 'g_ple': g_ple,
            'w_ple_up': w_ple_up, 'w_ple_gate': w_ple_gate, 'g_final': g_final}


def reference(x, p, g_mix, w_in, conv_w, conv_b, b_gate, gn_m, ln_g, ln_b, w_s, b_s,
              w_bm, w_bg, w_out, g_ffn, w_rg, b_rg, w_re, b_re, w1, w3, w2,
              g_ple, w_ple_up, w_ple_gate, g_final):
    for i in range(DEPTH):
        x = x + token_mixers(rms_norm(x, g_mix[i]), w_in[i], conv_w[i], conv_b[i], b_gate[i], gn_m[i],
                             ln_g[i], ln_b[i], w_s[i], b_s[i], w_bm[i], w_bg[i], w_out[i])
        x = x + hier_moe(rms_norm(x, g_ffn[i]), w_rg[i], b_rg[i], w_re[i], b_re[i], w1[i], w3[i], w2[i])
        ple = p[i] @ w_ple_up[i]
        x = x + jax.nn.sigmoid(rms_norm(x, g_ple[i]) @ w_ple_gate[i]) * ple
    return rms_norm(x, g_final)
```

```cpp
#include <hip/hip_runtime.h>
#include <cstdio>
#include <cstdint>

#define LAS __attribute__((address_space(3)))
#define GAS __attribute__((address_space(1)))
typedef unsigned short bf16_t;
typedef short bf16x8 __attribute__((ext_vector_type(8)));
typedef float f32x4 __attribute__((ext_vector_type(4)));
typedef float f32x2 __attribute__((ext_vector_type(2)));
typedef unsigned u32x4 __attribute__((ext_vector_type(4)));
typedef unsigned u32x2 __attribute__((ext_vector_type(2)));
typedef GAS unsigned gu32;

#ifndef MK_N_LAUNCHES
#define MK_N_LAUNCHES 1
#endif
constexpr int NPHASE = 14;
constexpr int N_LAUNCHES = MK_N_LAUNCHES;
#ifndef PHASE_MASK
#define PHASE_MASK 0x3fff
#endif
#ifndef REPEAT_MASK
#define REPEAT_MASK 0
#endif

constexpr int D = 2048, BATCH = 4, SEQ = 4096, M = BATCH * SEQ;
constexpr int MW = 1024, MH = 4, DH = 256, GW = 1024, NEXP = 32, DE = 512, PLE = 256;
constexpr int INC = 10248, NG1 = 10240;
constexpr int LC = 256, NCH = SEQ / LC;
constexpr float EPS = 1e-6f;
constexpr int NWAVES = 8, NTHR = 512;

constexpr size_t MiB = 1u << 20;
constexpr size_t WS_CTL = 0, CTL_ZERO_BYTES = 1 * MiB;
constexpr size_t WS_R0 = 1 * MiB;
constexpr size_t WS_DUMP = WS_R0;
constexpr size_t WS_GATEPRE = WS_R0 + 65536;
constexpr size_t WS_GC = WS_GATEPRE + 524288;
constexpr size_t WS_NLOC = WS_GC + 4096;
constexpr size_t WS_DENPART = WS_NLOC + 262144;
constexpr size_t WS_DENINTER = WS_DENPART + 1048576;
constexpr size_t WS_R1 = WS_DENINTER + 262144;
constexpr size_t WS_R2 = WS_R1 + 65536;
constexpr size_t WS_LIST = 4 * MiB;
constexpr size_t WS_LISTW = 6 * MiB;
constexpr size_t WS_SSQ3 = 8 * MiB;
static_assert(WS_R2 + 65536 <= WS_LIST, "small map");
constexpr size_t WS_WB = 16 * MiB, WS_WOUT = 24 * MiB, WS_WPG = 32 * MiB, WS_WPU = 40 * MiB, WS_WSBLK = 41 * MiB;
constexpr size_t WS_WIN = 42 * MiB;
constexpr size_t WS_XB = 82 * MiB;
constexpr size_t WS_PB = 146 * MiB;
constexpr size_t WS_PLEV = 154 * MiB;
constexpr size_t WS_QRAW = 218 * MiB, WS_KRAW = 250 * MiB, WS_VGT = 282 * MiB, WS_VT = 314 * MiB, WS_SO = 346 * MiB, WS_GU = 378 * MiB;
constexpr size_t WS_GATES = 410 * MiB;
constexpr size_t WS_VNT = 538 * MiB;
constexpr size_t WS_HG = 570 * MiB;
constexpr size_t WS_END = 602 * MiB;
constexpr size_t WS_QS = 42 * MiB, WS_KS = 74 * MiB, WS_KST = 106 * MiB;
constexpr size_t WS_P = 218 * MiB, WS_KVT = 250 * MiB;
constexpr size_t WS_CPT = 74 * MiB;
constexpr size_t WS_HM = 106 * MiB;
constexpr size_t WS_MERGED = 250 * MiB;
constexpr size_t WS_MIX = 42 * MiB;
constexpr size_t WS_X1B = 250 * MiB;
constexpr size_t WS_GP = 42 * MiB;
constexpr size_t WS_W13 = 410 * MiB;
constexpr size_t WS_W2 = 346 * MiB;
constexpr size_t WS_H = 106 * MiB;
constexpr size_t WS_Y = 410 * MiB;
constexpr int CW_TMO = 0;
constexpr int CW_CNT = 1024;
constexpr int CW_BAR = 4096;

constexpr int RING_BYTES = 131072;
constexpr int XTR_OFF = RING_BYTES;
constexpr int LDSCTL_OFF = RING_BYTES + 24576, MISC_OFF = LDSCTL_OFF + 320;
constexpr int LDS_BYTES = 163840;

#define RLX_AGENT __ATOMIC_RELAXED, __HIP_MEMORY_SCOPE_AGENT
#define LDS_WAIT() asm volatile("s_waitcnt lgkmcnt(0)" ::: "memory")
#define VM_WAIT() asm volatile("s_waitcnt vmcnt(0)" ::: "memory")
__device__ __forceinline__ unsigned f2bf(float f) { unsigned u = __builtin_bit_cast(unsigned, f); return (u + 0x7fffu + ((u >> 16) & 1u)) >> 16; }

typedef __bf16 bf16v2_t __attribute__((ext_vector_type(2)));
typedef float f32v2_t __attribute__((ext_vector_type(2)));
__device__ __forceinline__ unsigned cvt_pk_bf16(float lo, float hi) { const f32v2_t v = {lo, hi}; return __builtin_bit_cast(unsigned, __builtin_convertvector(v, bf16v2_t)); }
__device__ __forceinline__ unsigned pk2(float lo, float hi) { return cvt_pk_bf16(lo, hi); }
__device__ __forceinline__ float bflo(unsigned w) { return __uint_as_float(w << 16); }
__device__ __forceinline__ float bfhi(unsigned w) { return __uint_as_float(w & 0xffff0000u); }
__device__ __forceinline__ float bf2f(bf16_t b) { return __uint_as_float((unsigned)b << 16); }
__device__ __forceinline__ float fsigmoid(float x) { return __builtin_amdgcn_rcpf(1.0f + __expf(-x)); }
__device__ __forceinline__ float fgelu_tanh(float x) { const float z = 1.5957691216f * (x + 0.044715f * x * x * x); return x * __builtin_amdgcn_rcpf(1.0f + __expf(-z)); }
__device__ __forceinline__ float fsilu(float x) { return x * __builtin_amdgcn_rcpf(1.0f + __expf(-x)); }
__device__ __forceinline__ float wave_sum(float v) {
#pragma unroll
    for (int o = 1; o < 64; o <<= 1) v += __shfl_xor(v, o);
    return v;
}


__device__ __forceinline__ __amdgpu_buffer_rsrc_t ws_rsrc(const unsigned char* ws) { return __builtin_amdgcn_make_buffer_rsrc((void*)ws, 0, 0xffffffffu, 0x00020000); }
__device__ __forceinline__ void wt16(const unsigned char* ws, const void* p, u32x4 v) { __builtin_amdgcn_raw_buffer_store_b128(v, ws_rsrc(ws), (unsigned)((const unsigned char*)p - ws), 0, 16); }
__device__ __forceinline__ void wt16f(const unsigned char* ws, const void* p, f32x4 v) { __builtin_amdgcn_raw_buffer_store_b128(__builtin_bit_cast(u32x4, v), ws_rsrc(ws), (unsigned)((const unsigned char*)p - ws), 0, 16); }
__device__ __forceinline__ void wt8(const unsigned char* ws, const void* p, u32x2 v) { __builtin_amdgcn_raw_buffer_store_b64(v, ws_rsrc(ws), (unsigned)((const unsigned char*)p - ws), 0, 16); }
__device__ __forceinline__ void wt4(const unsigned char* ws, const void* p, unsigned v) { __builtin_amdgcn_raw_buffer_store_b32(v, ws_rsrc(ws), (unsigned)((const unsigned char*)p - ws), 0, 16); }
__device__ __forceinline__ void wt4f(const unsigned char* ws, const void* p, float v) { __builtin_amdgcn_raw_buffer_store_b32(__builtin_bit_cast(unsigned, v), ws_rsrc(ws), (unsigned)((const unsigned char*)p - ws), 0, 16); }

#define XB_TMO      128
#define XB_XCNT(j)  (256  + 64 * (j))
#define XB_XSUB(j)  (1280 + 64 * (j))
#define XB_XGEN(j)  (2304 + 64 * (j))
#define XB_TOP      3328
#define XB_TOPGEN   3392
#define XCD_BAR_WORDS 3456
#define XB_SPIN_CAP (1u << 18)
__device__ __forceinline__ unsigned xb_ld(unsigned* p)              { return __hip_atomic_load(p, __ATOMIC_RELAXED, __HIP_MEMORY_SCOPE_AGENT); }
__device__ __forceinline__ unsigned xb_add(unsigned* p, unsigned v) { return __hip_atomic_fetch_add(p, v, __ATOMIC_RELAXED, __HIP_MEMORY_SCOPE_AGENT); }
__device__ __forceinline__ unsigned xb_xcc_id() { return (unsigned)__builtin_amdgcn_s_getreg((3 << 11) | 20) & 0xFu; }
#define XB_SPIN(cond, bar) do { unsigned _sp = 0; while (cond) { __builtin_amdgcn_s_sleep(1); \
    if ((++_sp & 255u) == 0u) { if (xb_ld(&(bar)[XB_TMO])) break; if (_sp > XB_SPIN_CAP) { atomicAdd(&(bar)[XB_TMO], 1u); break; } } } } while (0)
struct XcdBarrier { unsigned* bar; unsigned x; volatile LAS unsigned* st; };
__device__ __forceinline__ XcdBarrier xcd_barrier_post(unsigned* bar, volatile LAS unsigned* st) {
    XcdBarrier b; b.bar = bar; b.x = xb_xcc_id(); b.st = st;
    if (threadIdx.x == 0) (void)xb_add(&bar[XB_XCNT(b.x)], 1u);
    return b;
}
__device__ __forceinline__ void xcd_barrier_complete(unsigned* bar, unsigned x, unsigned& nloc, unsigned& nx) {
    const unsigned G = gridDim.x * gridDim.y * gridDim.z;
    unsigned sum, cnt, mine, sp = 0u;
    for (;;) {
        sum = 0u; cnt = 0u; mine = 0u;
#pragma unroll
        for (unsigned j = 0; j < 16; ++j) { const unsigned c = xb_ld(&bar[XB_XCNT(j)]); sum += c; cnt += (c > 0u) ? 1u : 0u; mine = (j == x) ? c : mine; }
        if (sum == G) break;
        __builtin_amdgcn_s_sleep(1);
        if ((++sp & 255u) == 0u) { if (xb_ld(&bar[XB_TMO])) break; if (sp > XB_SPIN_CAP) { atomicAdd(&bar[XB_TMO], 1u); break; } }
    }
    nloc = mine > 0u ? mine : 1u; nx = cnt > 0u ? cnt : 1u;
}
__device__ __forceinline__ void xcd_barrier(const XcdBarrier& b) {
    asm volatile("s_waitcnt vmcnt(0)" ::: "memory");
    __syncthreads();
    if (threadIdx.x == 0) {
        unsigned* bar = b.bar;
        __builtin_amdgcn_s_waitcnt(0);
        asm volatile("buffer_inv sc1" ::: "memory");
        unsigned nloc = b.st[0], nx = b.st[1]; const unsigned k = b.st[2]; b.st[2] = k + 1u;
        if (nloc == 0u) { xcd_barrier_complete(bar, b.x, nloc, nx); b.st[0] = nloc; b.st[1] = nx; }
        const unsigned old = xb_add(&bar[XB_XSUB(b.x)], 1u);
        const unsigned gen = old / nloc;
        if (old + 1u == (gen + 1u) * nloc) {
            const unsigned og = xb_add(&bar[XB_TOP], 1u);
            const unsigned tg = og / nx;
            if (og + 1u == (tg + 1u) * nx) xb_add(&bar[XB_TOPGEN], 1u);
        }
        XB_SPIN(xb_ld(&bar[XB_TOPGEN]) == k, bar);
        asm volatile("s_waitcnt vmcnt(0)" ::: "memory");
    }
    __syncthreads();
}

namespace eng {
__device__ __forceinline__ int lane_id2() { int l; asm volatile("v_mbcnt_lo_u32_b32 %0, -1, 0\n\tv_mbcnt_hi_u32_b32 %0, -1, %0" : "=v"(l)); return l; }
constexpr int BM = 256, BK = 64, HALF = 128, HTB = HALF * BK * 2, NXCD = 8, WGM = 8;
__host__ __device__ __forceinline__ int lds_byte(int r, int c) { const int st = (r >> 4) * 2 + (c >> 5), rr = r & 15, cc = c & 31, ob = rr * 64 + cc * 2; return st * 1024 + (ob ^ (((ob >> 9) & 1) << 5)); }
__host__ __device__ __forceinline__ void stage_rc(int b, int& R, int& C) { const int st = b / 1024, sb = b % 1024, swz = sb ^ (((sb >> 9) & 1) << 5); R = (st >> 1) * 16 + swz / 64; C = (st & 1) * 32 + (swz % 64) / 2; }
__host__ __device__ __forceinline__ int perm32(int rho) { const int n = rho >> 4, i = rho & 15; return 8 * (i >> 2) + 4 * n + (i & 3); }

struct Unit { int pm, pn, ex; };
struct USrc { const char* a0; const char* a1; const char* b0; const char* b1; };

struct StaticOrder {
    int nM, nN, nwg, G, c;
    __device__ void init(int Mr, int Nc, int G_, int c_) { nM = Mr / BM; nN = Nc / BM; nwg = nM * nN; G = G_; c = c_; }
    __device__ bool next(int i, Unit& u) const {
        const long L = (long)i * G + c; if (L >= nwg) return false;
        int wgid = (int)L; { const int q = nwg / NXCD, r = nwg % NXCD, xcd = wgid % NXCD, off = wgid / NXCD; wgid = (xcd < r ? xcd * (q + 1) : r * (q + 1) + (xcd - r) * q) + off; }
        const int nig = WGM * nN, gid = wgid / nig, fm = gid * WGM, gsz = (nM - fm) < WGM ? (nM - fm) : WGM;
        u.pm = fm + ((wgid % nig) % gsz); u.pn = (wgid % nig) / gsz; u.ex = 0; return true;
    }
};

template <class Prob>
__device__ __forceinline__ void gemm_phase(LAS unsigned char* lds, const Prob& P, const int wave_id) {
    constexpr int NSEG = Prob::NSEG;
    int lane; asm volatile("v_mbcnt_lo_u32_b32 %0, -1, 0\n\tv_mbcnt_hi_u32_b32 %0, -1, %0" : "=v"(lane));
    const int wid = wave_id, tid = wid * 64 + lane, wr = wid >> 2, wc = wid & 3, fr = lane & 15, fq = lane >> 4;
    int nt = P.nt; asm volatile("" : "+s"(nt));
    const int ksw = P.ksw;
    unsigned Rg0, Rbg0, Cg0;
    { int R, C; stage_rc(tid * 16, R, C); Rg0 = (unsigned)R; Cg0 = (unsigned)C * 2u; asm volatile("" : "+v"(Rg0), "+v"(Cg0));
      if (Prob::PERM) { Rbg0 = (unsigned)((R & ~31) + perm32(R & 31)); asm volatile("" : "+v"(Rbg0)); } else Rbg0 = Rg0; }
    const unsigned ldsw = (unsigned)wid * 1024u;
    const int aoff = lds_byte(wr * 64 + fr, fq * 8), boff = lds_byte(wc * 32 + fr, fq * 8);
    unsigned ag[2][2], agn[2][2];
#define EG_SA(b, h) (((b) * 2 + (h)) * HTB)
#define EG_SB(b, h) ((4 + (b) * 2 + (h)) * HTB)
#define EG_STAGE_B(bufoff, p0, p1, kt, h) do { const bool _sg = (NSEG == 2) && ((kt) >= ksw); const unsigned _ld = _sg ? Prob::ldb1 : Prob::ldb0; \
        const char* _p = _sg ? (p1) + (size_t)((kt) - ksw) * 128 + (size_t)(h) * 128 * Prob::ldb1 : (p0) + (size_t)(kt) * 128 + (size_t)(h) * 128 * Prob::ldb0; \
        const unsigned _vo = Rbg0 * _ld + Cg0; \
        __builtin_amdgcn_global_load_lds((const unsigned*)(_p + _vo), (LAS unsigned*)(lds + (bufoff) + ldsw), 16, 0, 0); \
        __builtin_amdgcn_global_load_lds((const unsigned*)(_p + (size_t)64 * _ld + _vo), (LAS unsigned*)(lds + (bufoff) + ldsw + 8192), 16, 0, 0); } while (0)
#define EG_STAGE_A(bufoff, p0, p1, kt, h) do { if constexpr (Prob::GATHER) { const char* _p = (p0) + (size_t)(kt) * 128; _Pragma("unroll") for (int _i = 0; _i < 2; ++_i) \
        __builtin_amdgcn_global_load_lds((const unsigned*)(_p + (use_n ? agn[h][_i] : ag[h][_i])), (LAS unsigned*)(lds + (bufoff) + ldsw + _i * 8192), 16, 0, 0); } \
    else { const bool _sg = (NSEG == 2) && ((kt) >= ksw); const unsigned _ld = _sg ? Prob::lda1 : Prob::lda0; \
        const char* _p = _sg ? (p1) + (size_t)((kt) - ksw) * 128 + (size_t)(h) * 128 * Prob::lda1 : (p0) + (size_t)(kt) * 128 + (size_t)(h) * 128 * Prob::lda0; \
        const unsigned _vo = Rg0 * _ld + Cg0; \
        __builtin_amdgcn_global_load_lds((const unsigned*)(_p + _vo), (LAS unsigned*)(lds + (bufoff) + ldsw), 16, 0, 0); \
        __builtin_amdgcn_global_load_lds((const unsigned*)(_p + (size_t)64 * _ld + _vo), (LAS unsigned*)(lds + (bufoff) + ldsw + 8192), 16, 0, 0); } } while (0)
#define EG_LDA(dst, b, h) do { _Pragma("unroll") for (int m = 0; m < 4; ++m) _Pragma("unroll") for (int k = 0; k < 2; ++k) dst[m][k] = *(const LAS bf16x8*)(lds + EG_SA(b, h) + aoff + m * 2048 + k * 1024); } while (0)
#define EG_LDB(dst, b, h) do { _Pragma("unroll") for (int n = 0; n < 2; ++n) _Pragma("unroll") for (int k = 0; k < 2; ++k) dst[n][k] = *(const LAS bf16x8*)(lds + EG_SB(b, h) + boff + n * 2048 + k * 1024); } while (0)
#define EG_MMA(ai, bj, At, Bt) do { __builtin_amdgcn_s_setprio(1); _Pragma("unroll") for (int m = 0; m < 4; ++m) _Pragma("unroll") for (int n = 0; n < 2; ++n) _Pragma("unroll") for (int k = 0; k < 2; ++k) \
        acc[ai][bj][m][n] = __builtin_amdgcn_mfma_f32_16x16x32_bf16(Bt[n][k], At[m][k], acc[ai][bj][m][n], 0, 0, 0); __builtin_amdgcn_s_setprio(0); } while (0)
#define EG_WAIT_V(n) asm volatile("s_waitcnt vmcnt(" #n ")" ::: "memory")
#define EG_WAIT_V8R(relax) do { if (relax) asm volatile("s_waitcnt vmcnt(%0)" :: "n"(8 + Prob::EPI_VM) : "memory"); else EG_WAIT_V(8); } while (0)
#define EG_WAIT_L(n) asm volatile("s_waitcnt lgkmcnt(" #n ")" ::: "memory")
#define EG_BAR __builtin_amdgcn_s_barrier()
#define EG_SCHED __builtin_amdgcn_sched_barrier(0)
    Unit cur, nxt; int ui = 0;
    if (!P.next(0, cur)) return;
    USrc sc, sn; P.src(cur, sc);
    if constexpr (Prob::GATHER) {
#pragma unroll
        for (int h = 0; h < 2; ++h)
#pragma unroll
            for (int i = 0; i < 2; ++i) { ag[h][i] = P.arow(cur, h * 128 + i * 64 + (int)Rg0) + Cg0; asm volatile("" : "+v"(ag[h][i])); }
    }
    u32x2 keep[2][4][2];
#pragma unroll
    for (int a = 0; a < 2; ++a)
#pragma unroll
        for (int m = 0; m < 4; ++m) { keep[a][m][0] = (u32x2){0u, 0u}; keep[a][m][1] = (u32x2){0u, 0u}; }
    f32x4 acc[2][2][4][2];
#pragma unroll
    for (int a = 0; a < 2; ++a)
#pragma unroll
        for (int b = 0; b < 2; ++b)
#pragma unroll
            for (int m = 0; m < 4; ++m)
#pragma unroll
                for (int n = 0; n < 2; ++n) acc[a][b][m][n] = (f32x4){0.f, 0.f, 0.f, 0.f};
    bf16x8 At[4][2], B0[2][2], B1[2][2];
    bool use_n = false;
    EG_STAGE_B(EG_SB(0, 0), sc.b0, sc.b1, 0, 0); EG_STAGE_B(EG_SB(0, 1), sc.b0, sc.b1, 0, 1); EG_STAGE_A(EG_SA(0, 0), sc.a0, sc.a1, 0, 0); EG_STAGE_A(EG_SA(0, 1), sc.a0, sc.a1, 0, 1);
    if (wr == 1) EG_BAR;
    EG_WAIT_V(2); EG_BAR;
    EG_STAGE_B(EG_SB(1, 0), sc.b0, sc.b1, 1, 0); EG_STAGE_A(EG_SA(1, 0), sc.a0, sc.a1, 1, 0); EG_STAGE_B(EG_SB(1, 1), sc.b0, sc.b1, 1, 1);
    EG_WAIT_V(6); EG_BAR;
    for (;;) {
        const bool has_next = P.next(ui + 1, nxt);
        if (has_next) P.src(nxt, sn); else sn = sc;
        for (int t = 0; t < nt; t += 2) {
            const bool last = (t == nt - 2);
            const char* qa0 = last ? sn.a0 : sc.a0; const char* qa1 = last ? sn.a1 : sc.a1; const char* qb0 = last ? sn.b0 : sc.b0; const char* qb1 = last ? sn.b1 : sc.b1;
            const int k2 = last ? 0 : t + 2, k3 = k2 + 1;
            if constexpr (Prob::HAS_MID) { if (t == P.mid_kt) { const int l2 = lane_id2(); P.mid(acc, keep, cur, wr, wc, l2 & 15, l2 >> 4); } }
            const bool relax = (Prob::EPI_VM > 0) && (t == 0) && (ui > 0);
            EG_LDB(B0, 0, 0); EG_LDB(B1, 0, 1); EG_SCHED; EG_LDA(At, 0, 0); if (!relax) EG_STAGE_A(EG_SA(1, 1), sc.a0, sc.a1, t + 1, 1);
            EG_WAIT_V8R(relax); EG_WAIT_L(0); EG_BAR; EG_MMA(0, 0, At, B0); EG_MMA(0, 1, At, B1); EG_BAR; EG_SCHED;
            if constexpr (Prob::GATHER) {
                if (last && has_next) {
#pragma unroll
                    for (int h = 0; h < 2; ++h)
#pragma unroll
                        for (int i = 0; i < 2; ++i) { agn[h][i] = P.arow(nxt, h * 128 + i * 64 + (int)Rg0) + Cg0; asm volatile("" : "+v"(agn[h][i])); }
                    use_n = true; }
            }
            EG_LDA(At, 0, 1); EG_STAGE_B(EG_SB(0, 0), qb0, qb1, k2, 0); EG_STAGE_B(EG_SB(0, 1), qb0, qb1, k2, 1); EG_STAGE_A(EG_SA(0, 0), qa0, qa1, k2, 0);
            EG_WAIT_V8R(relax); EG_WAIT_L(0); EG_BAR; EG_MMA(1, 0, At, B0); EG_MMA(1, 1, At, B1); EG_BAR; EG_SCHED;
            EG_LDB(B0, 1, 0); EG_LDB(B1, 1, 1); EG_SCHED; EG_LDA(At, 1, 0); EG_STAGE_A(EG_SA(0, 1), qa0, qa1, k2, 1);
            EG_WAIT_V8R(relax); EG_WAIT_L(0); EG_BAR; EG_MMA(0, 0, At, B0); EG_MMA(0, 1, At, B1); EG_BAR; EG_SCHED;
            EG_LDA(At, 1, 1); EG_STAGE_B(EG_SB(1, 0), qb0, qb1, k3, 0); EG_STAGE_B(EG_SB(1, 1), qb0, qb1, k3, 1); EG_STAGE_A(EG_SA(1, 0), qa0, qa1, k3, 0);
            EG_WAIT_V(8); EG_WAIT_L(0); EG_BAR; EG_MMA(1, 0, At, B0); EG_MMA(1, 1, At, B1); EG_BAR; EG_SCHED;
        }
        if constexpr (Prob::EPI_VM > 0) { if (has_next) EG_STAGE_A(EG_SA(1, 1), sn.a0, sn.a1, 1, 1); }
        if constexpr (Prob::ALIGN) { if (wr == 0) EG_BAR; }
        if constexpr (!Prob::AFTER_DRAIN) { const int l2 = lane_id2(); if constexpr (Prob::HAS_MID) P.epi_keep(acc, keep, cur, wr, wc, l2 & 15, l2 >> 4); else P.epi(acc, cur, wr, wc, l2 & 15, l2 >> 4); }
        if (!has_next) break;
#pragma unroll
        for (int a = 0; a < 2; ++a)
#pragma unroll
            for (int b = 0; b < 2; ++b)
#pragma unroll
                for (int m = 0; m < 4; ++m)
#pragma unroll
                    for (int n = 0; n < 2; ++n) acc[a][b][m][n] = (f32x4){0.f, 0.f, 0.f, 0.f};
        cur = nxt; sc = sn; ++ui;
        if constexpr (Prob::GATHER) { ag[0][0] = agn[0][0]; ag[0][1] = agn[0][1]; ag[1][0] = agn[1][0]; ag[1][1] = agn[1][1]; use_n = false; }
        if constexpr (Prob::ALIGN) { if (wr == 1) EG_BAR; }
    }
    EG_WAIT_V(0);
    if constexpr (!Prob::ALIGN) { if (wr == 0) EG_BAR; }
    EG_BAR;
    if constexpr (Prob::AFTER_DRAIN) { const int l2 = lane_id2(); P.fused(acc, cur, wr, wc, l2 & 15, l2 >> 4, lds, wid, l2); }
#undef EG_SA
#undef EG_SB
#undef EG_STAGE_A
#undef EG_STAGE_B
#undef EG_LDA
#undef EG_LDB
#undef EG_MMA
#undef EG_WAIT_V
#undef EG_WAIT_V8R
#undef EG_WAIT_L
#undef EG_BAR
#undef EG_SCHED
}
}
using eng::Unit; using eng::USrc;
typedef f32x4 Acc[2][2][4][2];

struct Frame {
    LAS unsigned char* lds;
    volatile LAS unsigned* MISC;
    gu32* ctl;
    int wave, vcu, G;
    float* out; unsigned char* ws;
};
#define WSP(T, off) ((T*)(F.ws + (off)))
__device__ __forceinline__ int lane_id() { int l; asm volatile("v_mbcnt_lo_u32_b32 %0, -1, 0\n\tv_mbcnt_hi_u32_b32 %0, -1, %0" : "=v"(l)); return l; }
#define E0(j) (512 * ((j) >> 1) + 8 * lane + 4 * ((j) & 1))
#define DECL_TID const int lane = lane_id(), tid = F.wave * 64 + lane; (void)tid; (void)lane;
struct Args { const float* in[27]; float* out; unsigned char* ws; int ph_lo, ph_hi; };
#define INP(i) (args.in[i])

__device__ __forceinline__ u32x4 pack8(const f32x4 v0, const f32x4 v1) { u32x4 w; w.x = cvt_pk_bf16(v0[0], v0[1]); w.y = cvt_pk_bf16(v0[2], v0[3]); w.z = cvt_pk_bf16(v1[0], v1[1]); w.w = cvt_pk_bf16(v1[2], v1[3]); return w; }
template <int ACT> __device__ __forceinline__ f32x4 act4(f32x4 v) {
    if (ACT == 1) { v[0] = fsigmoid(v[0]); v[1] = fsigmoid(v[1]); v[2] = fsigmoid(v[2]); v[3] = fsigmoid(v[3]); }
    if (ACT == 2) { v[0] = fgelu_tanh(v[0]); v[1] = fgelu_tanh(v[1]); v[2] = fgelu_tanh(v[2]); v[3] = fgelu_tanh(v[3]); }
    return v;
}

constexpr int TSCR_BYTES = 64 * 65 * 4;
__device__ __forceinline__ void transpose_item(const unsigned char* ws_base_, const float* slp, size_t srcld, const float* ksc, int k0, bf16_t* dst, size_t dstld, LAS float* scr, int lane) {
    const int kr = lane >> 4, ns = (lane & 15) * 4;
    f32x4 v[16];
#pragma unroll
    for (int i = 0; i < 16; ++i) v[i] = __builtin_nontemporal_load((const GAS f32x4*)(slp + (size_t)(k0 + 4 * i + kr) * srcld));
#pragma unroll
    for (int i = 0; i < 16; ++i) { const int kk = 4 * i + kr; f32x4 w = v[i]; if (ksc) w = w * ksc[k0 + kk];
        LAS float* p = scr + kk * 65 + ns; p[0] = w[0]; p[1] = w[1]; p[2] = w[2]; p[3] = w[3]; }
    LDS_WAIT(); asm volatile("" ::: "memory");
    const int c = lane & 7, nl = lane >> 3;
#pragma unroll
    for (int p = 0; p < 8; ++p) { const int n = 8 * p + nl; const LAS float* q = scr + (8 * c) * 65 + n;
        u32x4 o; o.x = pk2(q[0 * 65], q[1 * 65]); o.y = pk2(q[2 * 65], q[3 * 65]); o.z = pk2(q[4 * 65], q[5 * 65]); o.w = pk2(q[6 * 65], q[7 * 65]);
        wt16(ws_base_, dst + (size_t)n * dstld + 8 * c, o); }
    LDS_WAIT(); asm volatile("" ::: "memory");
}
struct CItem { const float* slp; size_t srcld; const float* ksc; int k0; bf16_t* dst; size_t dstld; };
__device__ __forceinline__ void citem_load(f32x4 (&v)[16], float (&sc)[16], const CItem& I, int lane) {
    const int kr = lane >> 4;
#pragma unroll
    for (int i = 0; i < 16; ++i) v[i] = __builtin_nontemporal_load((const GAS f32x4*)(I.slp + (size_t)(I.k0 + 4 * i + kr) * I.srcld));
#pragma unroll
    for (int i = 0; i < 16; ++i) sc[i] = I.ksc ? I.ksc[I.k0 + 4 * i + kr] : 1.0f;
}
__device__ __forceinline__ void citem_to_lds(const f32x4 (&v)[16], const float (&sc)[16], LAS float* scr, int lane) {
    const int kr = lane >> 4, ns = (lane & 15) * 4;
#pragma unroll
    for (int i = 0; i < 16; ++i) { const int kk = 4 * i + kr; const f32x4 w = v[i] * sc[i]; LAS float* p = scr + kk * 65 + ns; p[0] = w[0]; p[1] = w[1]; p[2] = w[2]; p[3] = w[3]; }
    LDS_WAIT(); asm volatile("" ::: "memory");
}
__device__ __forceinline__ void citem_emit(const unsigned char* ws_base_, const CItem& I, LAS float* scr, int lane) {
    const int c = lane & 7, nl = lane >> 3;
#pragma unroll
    for (int p = 0; p < 8; ++p) { const int n = 8 * p + nl; const LAS float* q = scr + (8 * c) * 65 + n;
        u32x4 o; o.x = pk2(q[0 * 65], q[1 * 65]); o.y = pk2(q[2 * 65], q[3 * 65]); o.z = pk2(q[4 * 65], q[5 * 65]); o.w = pk2(q[6 * 65], q[7 * 65]);
        wt16(ws_base_, I.dst + (size_t)n * I.dstld + 8 * c, o); }
    LDS_WAIT(); asm volatile("" ::: "memory");
}

__device__ __forceinline__ void p0_prologue(Frame& F, const Args& args) {
    const unsigned char* ws_base_ = F.ws;
    LAS float* scr = (LAS float*)(F.lds + F.wave * TSCR_BYTES);
    DECL_TID; const int gw = F.vcu * NWAVES + F.wave, NGW = F.G * NWAVES;
    const float* w_in = INP(3); const float* g_mix = INP(2);
    constexpr int I_IN = 32 * 160, I_BM = 16 * 32, I_BG = 16 * 32, I_OUT = 32 * 32, I_PG = 32 * 32, I_PU = 4 * 32;
    constexpr int NITEMS = I_IN + I_BM + I_BG + I_OUT + I_PG + I_PU;
    const int ns4 = (lane & 15) * 4;
    for (int it = gw; it < NITEMS; it += NGW) {
        int r = it;
        if (r < I_IN) { const int kb = r / 160, nb = r % 160, d0 = nb * 64, sc0 = d0 < 4096 ? d0 : d0 + 8;
            transpose_item(F.ws, w_in + sc0 + ns4, INC, g_mix, kb * 64, WSP(bf16_t, WS_WIN) + (size_t)d0 * D + kb * 64, D, scr, lane); continue; } r -= I_IN;
        if (r < I_BM) { const int kb = r / 32, nb = r % 32;
            transpose_item(F.ws, INP(12) + nb * 64 + ns4, D, nullptr, kb * 64, WSP(bf16_t, WS_WB) + (size_t)(nb * 64) * D + kb * 64, D, scr, lane); continue; } r -= I_BM;
        if (r < I_BG) { const int kb = r / 32, nb = r % 32;
            transpose_item(F.ws, INP(13) + nb * 64 + ns4, D, nullptr, kb * 64, WSP(bf16_t, WS_WB) + (size_t)(nb * 64) * D + MW + kb * 64, D, scr, lane); continue; } r -= I_BG;
        if (r < I_OUT) { const int kb = r / 32, nb = r % 32;
            transpose_item(F.ws, INP(14) + nb * 64 + ns4, D, nullptr, kb * 64, WSP(bf16_t, WS_WOUT) + (size_t)(nb * 64) * D + kb * 64, D, scr, lane); continue; } r -= I_OUT;
        if (r < I_PG) { const int kb = r / 32, nb = r % 32;
            transpose_item(F.ws, INP(25) + nb * 64 + ns4, D, INP(23), kb * 64, WSP(bf16_t, WS_WPG) + (size_t)(nb * 64) * D + kb * 64, D, scr, lane); continue; } r -= I_PG;
        { const int kb = r / 32, nb = r % 32;
            transpose_item(F.ws, INP(24) + nb * 64 + ns4, D, nullptr, kb * 64, WSP(bf16_t, WS_WPU) + (size_t)(nb * 64) * PLE + kb * 64, PLE, scr, lane); }
    }
    const int gt = F.vcu * NTHR + tid, NGT = F.G * NTHR;
    { const float* w_s = INP(10); bf16_t* wsb = WSP(bf16_t, WS_WSBLK);
      for (int i2 = gt; i2 < 4 * 256 * 256 / 2; i2 += NGT) { const int idx = i2 * 2, gp = idx >> 16, r = (idx >> 8) & 255, c = idx & 255, gi = r >> 7, t = r & 127, gj = c >> 7, s = c & 127;
          const float v0 = (gi == gj && s <= t) ? w_s[(size_t)(2 * gp + gi) * 16384 + t * 128 + s] : 0.f, v1 = (gi == gj && s + 1 <= t) ? w_s[(size_t)(2 * gp + gi) * 16384 + t * 128 + s + 1] : 0.f;
          wt4(ws_base_, wsb + idx, pk2(v0, v1)); } }
    { const float* p = INP(1); bf16_t* pb = WSP(bf16_t, WS_PB);
      for (int idx = gt; idx < M * PLE / 8; idx += NGT) { const f32x4 a = *(const GAS f32x4*)(p + (size_t)idx * 8), b = *(const GAS f32x4*)(p + (size_t)idx * 8 + 4);
          u32x4 o; o.x = pk2(a[0], a[1]); o.y = pk2(a[2], a[3]); o.z = pk2(b[0], b[1]); o.w = pk2(b[2], b[3]); wt16(ws_base_, pb + (size_t)idx * 8, o); } }
    __syncthreads();
    LAS float* g8 = (LAS float*)F.lds;
    for (int idx = tid; idx < 8 * D; idx += NTHR) { const int k = idx >> 3, j = idx & 7; g8[j * D + k] = w_in[(size_t)k * INC + 4096 + j] * g_mix[k]; }
    __syncthreads();
    { const float* x = INP(0); const float* b_gate = INP(6); bf16_t* xb = WSP(bf16_t, WS_XB); float* gp = WSP(float, WS_GATEPRE);
      for (int m = gw; m < M; m += NGW) {
          const float* xrow = x + (size_t)m * D;
          f32x4 v[8]; float ss = 0.f;
#pragma unroll
          for (int j = 0; j < 8; ++j) { v[j] = *(const GAS f32x4*)(xrow + E0(j)); ss += (v[j][0] * v[j][0] + v[j][1] * v[j][1]) + (v[j][2] * v[j][2] + v[j][3] * v[j][3]); }
          float mine = 0.f;
#pragma unroll 1
          for (int g = 0; g < 8; ++g) { float a = 0.f;
#pragma unroll
              for (int j = 0; j < 8; ++j) { const f32x4 w = *(const LAS f32x4*)(g8 + g * D + E0(j)); a += (v[j][0] * w[0] + v[j][1] * w[1]) + (v[j][2] * w[2] + v[j][3] * w[3]); }
              a = wave_sum(a); mine = (lane == g) ? a : mine; }
          ss = wave_sum(ss);
          const float r = 1.0f / sqrtf(ss * (1.0f / D) + EPS);
#pragma unroll
          for (int p = 0; p < 4; ++p) wt16(ws_base_, xb + (size_t)m * D + 512 * p + 8 * lane, pack8(v[2 * p] * r, v[2 * p + 1] * r));
          if (lane < 8) wt4f(ws_base_, gp + (size_t)m * 8 + lane, r * mine + b_gate[lane]);
      } }
    __syncthreads();
}

struct ProbG1 {
    static constexpr int EPI_VM = 8;  static constexpr bool PERM = true, AFTER_DRAIN = false, ALIGN = true, HAS_MID = false, GATHER = false; static constexpr int NSEG = 1; static constexpr unsigned lda0 = 4096u, lda1 = 4096u, ldb0 = 4096u, ldb1 = 4096u;
    int nt, ksw, mid_kt; eng::StaticOrder S; unsigned char* ws;
    __device__ __forceinline__ bool next(int i, Unit& u) const { return S.next(i, u); }
    __device__ __forceinline__ void src(const Unit& u, USrc& s) const {
        const int cb = u.pn >> 2; const bool sw = (cb == 2 || cb == 5);
        const char* xa = (const char*)(ws + WS_XB) + (size_t)u.pm * 256 * 4096; const char* wa = (const char*)(ws + WS_WIN) + (size_t)u.pn * 256 * 4096;
        s.a0 = sw ? wa : xa; s.b0 = sw ? xa : wa; s.a1 = s.a0; s.b1 = s.b0;
    }
    template <int ACT> __device__ __forceinline__ void epi_nat(const Acc& acc, const Unit& u, int wr, int wc, int fr, int fq, bf16_t* dst, int ldd, int colt) const {
        const unsigned char* ws_base_ = ws;
        const int row0 = u.pm * 256 + wr * 64 + fr, col0 = colt + wc * 32 + 8 * fq;
#pragma unroll
        for (int ai = 0; ai < 2; ++ai)
#pragma unroll
            for (int m = 0; m < 4; ++m) { const int row = row0 + ai * 128 + m * 16; bf16_t* rowp = dst + (size_t)row * ldd + col0;
#pragma unroll
                for (int bj = 0; bj < 2; ++bj) { const f32x4 v0 = act4<ACT>(acc[ai][bj][m][0]), v1 = act4<ACT>(acc[ai][bj][m][1]);
                    wt16(ws_base_, rowp + bj * 128, pack8(v0, v1)); } }
    }
    template <int ACT, bool CHUNKED> __device__ __forceinline__ void epi_swp(const Acc& acc, const Unit& u, int wr, int wc, int fr, int fq, bf16_t* dst) const {
        const unsigned char* ws_base_ = ws;
        const int ch0 = (u.pn & 3) * 256 + wr * 64 + fr, tk0 = u.pm * 256 + wc * 32 + 8 * fq;
#pragma unroll
        for (int ai = 0; ai < 2; ++ai)
#pragma unroll
            for (int m = 0; m < 4; ++m) { bf16_t* rowp = CHUNKED ? dst + ((size_t)(((u.pm >> 4) * MH + (u.pn & 3)) * NCH + (u.pm & 15)) * 256 + (wr * 64 + fr + ai * 128 + m * 16)) * 256 + wc * 32 + 8 * fq
                                                                       : dst + (size_t)(ch0 + ai * 128 + m * 16) * M + tk0;
#pragma unroll
                for (int bj = 0; bj < 2; ++bj) { const f32x4 v0 = act4<ACT>(acc[ai][bj][m][0]), v1 = act4<ACT>(acc[ai][bj][m][1]);
                    wt16(ws_base_, rowp + bj * 128, pack8(v0, v1)); } }
    }
    static __device__ __forceinline__ unsigned pack4u8(const f32x4 v, const unsigned lo) {
        const unsigned q0 = max((unsigned)fmaf(v[0], 255.f, 0.5f), lo), q1 = max((unsigned)fmaf(v[1], 255.f, 0.5f), lo), q2 = max((unsigned)fmaf(v[2], 255.f, 0.5f), lo), q3 = max((unsigned)fmaf(v[3], 255.f, 0.5f), lo);
        return q0 | (q1 << 8) | (q2 << 16) | (q3 << 24); }
    __device__ __forceinline__ void epi_gate8(const Acc& acc, const Unit& u, int wr, int wc, int fr, int fq) const {
        const unsigned char* ws_base_ = ws; unsigned char* gt = ws + WS_GATES + (size_t)(u.pm * 16 + (u.pn - 24)) * 65536;
        const unsigned lo = u.pn >= 32 ? 1u : 0u; const bool odd = (fq & 1) != 0;
        const int lofs = (odd ? 512 : 0) + fr * 32 + (fq & ~1) * 8;
#pragma unroll
        for (int ai = 0; ai < 2; ++ai)
#pragma unroll
            for (int m = 0; m < 4; ++m) { const int q = ((ai * 2 + wr) * 4 + m) * 4 + wc;
                u32x2 w0, w1;
                w0.x = pack4u8(act4<1>(acc[ai][0][m][0]), lo); w0.y = pack4u8(act4<1>(acc[ai][0][m][1]), lo);
                w1.x = pack4u8(act4<1>(acc[ai][1][m][0]), lo); w1.y = pack4u8(act4<1>(acc[ai][1][m][1]), lo);
                const unsigned sx = odd ? w0.x : w1.x, sy = odd ? w0.y : w1.y;
                const unsigned px = (unsigned)__shfl_xor((int)sx, 16), py = (unsigned)__shfl_xor((int)sy, 16);
                u32x4 o; if (!odd) { o.x = w0.x; o.y = w0.y; o.z = px; o.w = py; } else { o.x = px; o.y = py; o.z = w1.x; o.w = w1.y; }
                wt16(ws_base_, gt + q * 1024 + lofs, o); }
    }
    __device__ __forceinline__ void epi(const Acc& acc, const Unit& u, int wr, int wc, int fr, int fq) const { asm volatile("" : "+v"(fr), "+v"(fq)); const unsigned char* ws_base_ = ws; (void)ws_base_;
        const int cb = u.pn >> 2, colt = (u.pn & 3) * 256;
        if (cb == 0) epi_nat<0>(acc, u, wr, wc, fr, fq, (bf16_t*)(ws + WS_QRAW), MW, colt);
        else if (cb == 1) epi_nat<0>(acc, u, wr, wc, fr, fq, (bf16_t*)(ws + WS_KRAW), MW, colt);
        else if (cb == 2) epi_swp<0, true>(acc, u, wr, wc, fr, fq, (bf16_t*)(ws + WS_VT));
        else if (cb == 3) epi_nat<1>(acc, u, wr, wc, fr, fq, (bf16_t*)(ws + WS_SO), MW, colt);
        else if (cb == 4) epi_nat<2>(acc, u, wr, wc, fr, fq, (bf16_t*)(ws + WS_GU), GW, colt);
        else if (cb == 5) epi_swp<2, false>(acc, u, wr, wc, fr, fq, (bf16_t*)(ws + WS_VGT));
        else epi_gate8(acc, u, wr, wc, fr, fq);
    }
};
struct ProbPU {
    static constexpr int EPI_VM = 16; static constexpr bool PERM = true, AFTER_DRAIN = false, ALIGN = true, HAS_MID = false, GATHER = false; static constexpr int NSEG = 1; static constexpr unsigned lda0 = 512u, lda1 = 512u, ldb0 = 512u, ldb1 = 512u;
    int nt, ksw, mid_kt; eng::StaticOrder S; unsigned char* ws;
    __device__ __forceinline__ bool next(int i, Unit& u) const { return S.next(i, u); }
    __device__ __forceinline__ void src(const Unit& u, USrc& s) const {
        s.a0 = s.a1 = (const char*)(ws + WS_PB) + (size_t)u.pm * 256 * 512; s.b0 = s.b1 = (const char*)(ws + WS_WPU) + (size_t)u.pn * 256 * 512;
    }
    __device__ __forceinline__ void epi(const Acc& acc, const Unit& u, int wr, int wc, int fr, int fq) const { asm volatile("" : "+v"(fr), "+v"(fq)); const unsigned char* ws_base_ = ws; (void)ws_base_;
        bf16_t* dst = (bf16_t*)(ws + WS_PLEV) + (size_t)(u.pm * 8 + u.pn) * 65536 + fr * 32 + fq * 8;
#pragma unroll
        for (int ai = 0; ai < 2; ++ai)
#pragma unroll
            for (int m = 0; m < 4; ++m)
#pragma unroll
                for (int bj = 0; bj < 2; ++bj) wt16(ws_base_, dst + ((((ai * 2 + wr) * 4 + m) * 4 + wc) * 2 + bj) * 512, pack8(acc[ai][bj][m][0], acc[ai][bj][m][1]));
    }
};

__device__ __forceinline__ void p2_elementwise(Frame& F, const Args& args) {
    const unsigned char* ws_base_ = F.ws;
    DECL_TID;
    LAS float* sb = (LAS float*)F.lds;
    LAS float* seq = sb + 256;
    LAS float* sek = sb + 512;
    LAS float* nl = sb + 1024;
    const float* gpre = WSP(float, WS_GATEPRE);
    const float* conv_w = INP(4); const float* conv_b = INP(5);
    for (int un = (int)blockIdx.x; un < BATCH * NCH * MH; un += F.G) {
        const int bh = un >> 4, c = un & 15, b = bh >> 2, h = bh & 3, t0 = b * SEQ + c * LC;
        float lf = 0.f, ip = 0.f;
        if (tid < 256) { const float fp = gpre[(size_t)(t0 + tid) * 8 + 4 + h]; ip = gpre[(size_t)(t0 + tid) * 8 + h];
            lf = fminf(fp, 0.f) - log1pf(__expf(-fabsf(fp))); sb[tid] = lf; }
        __syncthreads();
        for (int o = 1; o < 256; o <<= 1) { float a = 0.f; if (tid < 256) { a = sb[tid]; if (tid >= o) a += sb[tid - o]; } __syncthreads(); if (tid < 256) sb[tid] = a; __syncthreads(); }
        if (tid < 256) { const float bl = sb[tid]; seq[tid] = __expf(bl); sek[tid] = __expf(ip - bl); if (tid == 255) wt4f(ws_base_, WSP(float, WS_GC) + bh * NCH + c, bl); }
        __syncthreads();
        for (int pass = 0; pass < 4; ++pass) {
            const bool isk = pass >= 2; const int blk = (pass & 1) * 512 + tid, ds = blk & 31, rg = blk >> 5, l0 = rg * 8, d0 = ds * 8;
            const int ch = (isk ? MW : 0) + h * DH + d0;
            const bf16_t* src = WSP(bf16_t, isk ? WS_KRAW : WS_QRAW) + (size_t)h * DH + d0;
            float w[4][8], bias[8];
#pragma unroll
            for (int j = 0; j < 4; ++j) { const f32x4 a = *(const GAS f32x4*)(conv_w + (size_t)j * 2048 + ch), bq = *(const GAS f32x4*)(conv_w + (size_t)j * 2048 + ch + 4);
                w[j][0] = a[0]; w[j][1] = a[1]; w[j][2] = a[2]; w[j][3] = a[3]; w[j][4] = bq[0]; w[j][5] = bq[1]; w[j][6] = bq[2]; w[j][7] = bq[3]; }
            { const f32x4 a = *(const GAS f32x4*)(conv_b + ch), bq = *(const GAS f32x4*)(conv_b + ch + 4); bias[0] = a[0]; bias[1] = a[1]; bias[2] = a[2]; bias[3] = a[3]; bias[4] = bq[0]; bias[5] = bq[1]; bias[6] = bq[2]; bias[7] = bq[3]; }
            u32x4 raw[11];
#pragma unroll
            for (int i = 0; i < 11; ++i) { const int l = l0 - 3 + i; const bool ok = (c > 0) || (l >= 0);
                raw[i] = ok ? *(const GAS u32x4*)(src + (size_t)(t0 + l) * MW) : (u32x4){0u, 0u, 0u, 0u}; }
            float val[8][8];
#pragma unroll
            for (int r = 0; r < 8; ++r) {
                float y[8];
#pragma unroll
                for (int d = 0; d < 8; ++d) y[d] = bias[d];
#pragma unroll
                for (int j = 0; j < 4; ++j) { const u32x4 x = raw[r + j];
                    y[0] += w[j][0] * bflo(x.x); y[1] += w[j][1] * bfhi(x.x); y[2] += w[j][2] * bflo(x.y); y[3] += w[j][3] * bfhi(x.y);
                    y[4] += w[j][4] * bflo(x.z); y[5] += w[j][5] * bfhi(x.z); y[6] += w[j][6] * bflo(x.w); y[7] += w[j][7] * bfhi(x.w); }
                const float sc = isk ? sek[l0 + r] * 0.0625f : seq[l0 + r];
#pragma unroll
                for (int d = 0; d < 8; ++d) val[r][d] = fsilu(y[d]) * sc;
            }
            bf16_t* dn = WSP(bf16_t, isk ? WS_KS : WS_QS) + (size_t)(bh * NCH + c) * 65536 + d0;
#pragma unroll
            for (int r = 0; r < 8; ++r) { u32x4 o; o.x = cvt_pk_bf16(val[r][0], val[r][1]); o.y = cvt_pk_bf16(val[r][2], val[r][3]); o.z = cvt_pk_bf16(val[r][4], val[r][5]); o.w = cvt_pk_bf16(val[r][6], val[r][7]);
                wt16(ws_base_, dn + (size_t)(l0 + r) * 256, o); }
            if (isk) {
                bf16_t* dt = WSP(bf16_t, WS_KST) + (size_t)(bh * NCH + c) * 65536 + (size_t)d0 * 256 + l0;
#pragma unroll
                for (int d = 0; d < 8; ++d) { u32x4 o; o.x = cvt_pk_bf16(val[0][d], val[1][d]); o.y = cvt_pk_bf16(val[2][d], val[3][d]); o.z = cvt_pk_bf16(val[4][d], val[5][d]); o.w = cvt_pk_bf16(val[6][d], val[7][d]);
                    wt16(ws_base_, dt + (size_t)d * 256, o); }
#pragma unroll
                for (int d = 0; d < 8; ++d) { float s = 0.f;
#pragma unroll
                    for (int r = 0; r < 8; ++r) s += val[r][d];
                    nl[rg * 256 + d0 + d] = s; }
            }
        }
        __syncthreads();
        if (tid < 256) { float s = 0.f;
#pragma unroll 8
            for (int rg = 0; rg < 32; ++rg) s += nl[rg * 256 + tid];
            wt4f(ws_base_, WSP(float, WS_NLOC) + (size_t)(bh * NCH + c) * 256 + tid, s); }
        __syncthreads();
    }
    LAS float* rs = (LAS float*)F.lds;
    LAS float* rq = rs + 4096;
    LAS float* smu = rq + 4096;
    LAS float* srs = smu + 64;
    const float* ln_g = INP(8); const float* ln_b = INP(9);
    for (int un = F.vcu; un < M / 64; un += F.G) {
        const int ts = tid & 7, cg = tid >> 3, tk = un * 64 + ts * 8;
        const bf16_t* src = WSP(bf16_t, WS_VGT) + (size_t)(cg * 16) * M + tk;
        u32x4 raw[16]; float s[8], q[8];
#pragma unroll
        for (int d = 0; d < 8; ++d) { s[d] = 0.f; q[d] = 0.f; }
#pragma unroll
        for (int i = 0; i < 16; ++i) { raw[i] = *(const GAS u32x4*)(src + (size_t)i * M);
            const float v0 = bflo(raw[i].x), v1 = bfhi(raw[i].x), v2 = bflo(raw[i].y), v3 = bfhi(raw[i].y), v4 = bflo(raw[i].z), v5 = bfhi(raw[i].z), v6 = bflo(raw[i].w), v7 = bfhi(raw[i].w);
            s[0] += v0; s[1] += v1; s[2] += v2; s[3] += v3; s[4] += v4; s[5] += v5; s[6] += v6; s[7] += v7;
            q[0] += v0 * v0; q[1] += v1 * v1; q[2] += v2 * v2; q[3] += v3 * v3; q[4] += v4 * v4; q[5] += v5 * v5; q[6] += v6 * v6; q[7] += v7 * v7; }
#pragma unroll
        for (int d = 0; d < 8; ++d) { rs[cg * 64 + ts * 8 + d] = s[d]; rq[cg * 64 + ts * 8 + d] = q[d]; }
        __syncthreads();
        if (tid < 64) { float a = 0.f, bq = 0.f;
#pragma unroll 8
            for (int g = 0; g < 64; ++g) { a += rs[g * 64 + tid]; bq += rq[g * 64 + tid]; }
            const float mu = a * (1.0f / GW), var = fmaxf(bq * (1.0f / GW) - mu * mu, 0.f); smu[tid] = mu; srs[tid] = 1.0f / sqrtf(var + EPS); }
        __syncthreads();
        float mu[8], rr[8];
#pragma unroll
        for (int d = 0; d < 8; ++d) { mu[d] = smu[ts * 8 + d]; rr[d] = srs[ts * 8 + d]; }
        const int chunk = tk >> 7, s0 = tk & 127;
#pragma unroll
        for (int i = 0; i < 16; ++i) { const int ch = cg * 16 + i; const float g = ln_g[ch], bb = ln_b[ch];
            const float v0 = (bflo(raw[i].x) - mu[0]) * rr[0] * g + bb, v1 = (bfhi(raw[i].x) - mu[1]) * rr[1] * g + bb, v2 = (bflo(raw[i].y) - mu[2]) * rr[2] * g + bb, v3 = (bfhi(raw[i].y) - mu[3]) * rr[3] * g + bb;
            const float v4 = (bflo(raw[i].z) - mu[4]) * rr[4] * g + bb, v5 = (bfhi(raw[i].z) - mu[5]) * rr[5] * g + bb, v6 = (bflo(raw[i].w) - mu[6]) * rr[6] * g + bb, v7 = (bfhi(raw[i].w) - mu[7]) * rr[7] * g + bb;
            u32x4 o; o.x = cvt_pk_bf16(v0, v1); o.y = cvt_pk_bf16(v2, v3); o.z = cvt_pk_bf16(v4, v5); o.w = cvt_pk_bf16(v6, v7);
            const int gp = ch >> 8, gj = (ch >> 7) & 1, e = ch & 127;
            wt16(ws_base_, WSP(bf16_t, WS_VNT) + ((((size_t)gp * 128 + chunk) * 128 + e) * 2 + gj) * 128 + s0, o); }
        __syncthreads();
    }
}

struct ProbP3 {
    static constexpr int EPI_VM = 16; static constexpr bool PERM = true, AFTER_DRAIN = false, ALIGN = true, HAS_MID = false, GATHER = false; static constexpr int NSEG = 1; static constexpr unsigned lda0 = 512u, lda1 = 512u, ldb0 = 512u, ldb1 = 512u;
    int nt, ksw, mid_kt; int G, c0, mode; unsigned char* ws; const float* b_s;
    __device__ __forceinline__ bool next(int i, Unit& u) const { u.pn = 0;
        if (mode == 0) { const int sub = (i >> 1) * G + c0; if (sub >= 256) return false; u.ex = i & 1; u.pm = sub; return true; }
        const int sub = i * G + c0; if (sub >= 256) return false; u.ex = 2; u.pm = sub; return true; }
    __device__ __forceinline__ void src(const Unit& u, USrc& s) const {
        const size_t blk = (size_t)u.pm * 65536 * 2;
        if (u.ex == 0) { s.a0 = (const char*)(ws + WS_QS) + blk; s.b0 = (const char*)(ws + WS_KS) + blk; }
        else if (u.ex == 1) { s.a0 = (const char*)(ws + WS_VT) + blk; s.b0 = (const char*)(ws + WS_KST) + blk; }
        else { const int gp = u.pm >> 6, cp = u.pm & 63; s.a0 = (const char*)(ws + WS_WSBLK) + (size_t)gp * 256 * 512; s.b0 = (const char*)(ws + WS_VNT) + ((size_t)gp * 16384 + cp * 256) * 512; }
        s.a1 = s.a0; s.b1 = s.b0;
    }
    __device__ __forceinline__ void epi_s(const Acc& acc, const Unit& u, int wr, int wc, int fr, int fq) const { const unsigned char* ws_base_ = ws;
        const int bh = u.pm >> 4, ch = u.pm & 15, b = bh >> 2, h = bh & 3; bf16_t* Pd = (bf16_t*)(ws + WS_P) + ((size_t)bh * SEQ + ch * LC) * 256; float* dp = (float*)(ws + WS_DENPART);
#pragma unroll
        for (int ai = 0; ai < 2; ++ai)
#pragma unroll
            for (int m = 0; m < 4; ++m) { const int l = ai * 128 + wr * 64 + m * 16 + fr; float rsum = 0.f;
#pragma unroll
                for (int bj = 0; bj < 2; ++bj) { const int s0 = bj * 128 + wc * 32 + 8 * fq; f32x4 v0 = acc[ai][bj][m][0], v1 = acc[ai][bj][m][1];
                    const float dl = (float)(l - s0 + 1);
#pragma unroll
                    for (int e = 0; e < 4; ++e) { v0[e] *= __builtin_amdgcn_fmed3f(dl - (float)e, 0.f, 1.f); v1[e] *= __builtin_amdgcn_fmed3f(dl - (float)(4 + e), 0.f, 1.f); }
                    rsum += (v0[0] + v0[1]) + (v0[2] + v0[3]) + (v1[0] + v1[1]) + (v1[2] + v1[3]);
                    wt16(ws_base_, Pd + (size_t)l * 256 + s0, pack8(v0, v1)); }
                rsum += __shfl_xor(rsum, 16); rsum += __shfl_xor(rsum, 32);
                if (fq == 0) wt4f(ws_base_, dp + ((size_t)(b * SEQ + ch * LC + l) * 4 + h) * 4 + wc, rsum); }
    }
    __device__ __forceinline__ void epi_kv(const Acc& acc, const Unit& u, int wr, int wc, int fr, int fq) const { const unsigned char* ws_base_ = ws;
        bf16_t* dst = (bf16_t*)(ws + WS_KVT) + (size_t)u.pm * 65536;
#pragma unroll
        for (int ai = 0; ai < 2; ++ai)
#pragma unroll
            for (int m = 0; m < 4; ++m) { bf16_t* rowp = dst + (size_t)(ai * 128 + wr * 64 + m * 16 + fr) * 256 + wc * 32 + 8 * fq;
#pragma unroll
                for (int bj = 0; bj < 2; ++bj) wt16(ws_base_, rowp + bj * 128, pack8(acc[ai][bj][m][0], acc[ai][bj][m][1])); }
    }
    __device__ __forceinline__ void epi_gm(const Acc& acc, const Unit& u, int wr, int wc, int fr, int fq) const { const unsigned char* ws_base_ = ws;
        const int gpi = u.pm >> 6, cp = u.pm & 63; const bf16_t* gu = (const bf16_t*)(ws + WS_GU); bf16_t* hg = (bf16_t*)(ws + WS_HG);
        u32x4 uu[2][4][2]; float bs[2][4];
#pragma unroll
        for (int ai = 0; ai < 2; ++ai) { const int g = 2 * gpi + ai;
#pragma unroll
            for (int m = 0; m < 4; ++m) { const int t = wr * 64 + m * 16 + fr; bs[ai][m] = b_s[g * 128 + t];
#pragma unroll
                for (int bj = 0; bj < 2; ++bj) uu[ai][m][bj] = *(const GAS u32x4*)(gu + (size_t)((cp * 2 + bj) * 128 + t) * GW + g * 128 + wc * 32 + 8 * fq); } }
#pragma unroll
        for (int ai = 0; ai < 2; ++ai) { const int g = 2 * gpi + ai;
#pragma unroll
            for (int m = 0; m < 4; ++m) { const int t = wr * 64 + m * 16 + fr;
#pragma unroll
                for (int bj = 0; bj < 2; ++bj) { const size_t o = (size_t)((cp * 2 + bj) * 128 + t) * GW + g * 128 + wc * 32 + 8 * fq; const u32x4 x = uu[ai][m][bj];
                    f32x4 v0 = acc[ai][bj][m][0] + bs[ai][m], v1 = acc[ai][bj][m][1] + bs[ai][m];
                    v0[0] *= bflo(x.x); v0[1] *= bfhi(x.x); v0[2] *= bflo(x.y); v0[3] *= bfhi(x.y); v1[0] *= bflo(x.z); v1[1] *= bfhi(x.z); v1[2] *= bflo(x.w); v1[3] *= bfhi(x.w);
                    wt16(ws_base_, hg + o, pack8(v0, v1)); } } }
    }
    __device__ __forceinline__ void epi(const Acc& acc, const Unit& u, int wr, int wc, int fr, int fq) const { asm volatile("" : "+v"(fr), "+v"(fq));
        if (u.ex == 0) epi_s(acc, u, wr, wc, fr, fq); else if (u.ex == 1) epi_kv(acc, u, wr, wc, fr, fq); else epi_gm(acc, u, wr, wc, fr, fq);
    }
};

__device__ __forceinline__ void p4_scan(Frame& F) {
    const unsigned char* ws_base_ = F.ws;
    DECL_TID;
    const float* gc = WSP(float, WS_GC);
    { const bf16_t* kv = WSP(const bf16_t, WS_KVT); bf16_t* cp = WSP(bf16_t, WS_CPT);
      const int gt = F.vcu * NTHR + tid, NGT = F.G * NTHR;
      for (int it = gt; it < 16 * 65536 / 8; it += NGT) { const int bh = it >> 13, ed = (it & 8191) * 8;
          u32x4 kq[NCH - 1]; float eg[NCH - 1];
#pragma unroll
          for (int c = 0; c < NCH - 1; ++c) { const size_t o = (size_t)(bh * NCH + c) * 65536 + ed; kq[c] = *(const GAS u32x4*)(kv + o); eg[c] = __expf(gc[bh * NCH + c]); }
          f32x4 C0 = (f32x4){0.f, 0.f, 0.f, 0.f}, C1 = C0;
#pragma unroll
          for (int c = 0; c < NCH; ++c) { const size_t o = (size_t)(bh * NCH + c) * 65536 + ed;
              wt16(ws_base_, cp + o, pack8(C0, C1));
              if (c < NCH - 1) { const u32x4 q = kq[c]; const f32x4 k0 = (f32x4){bflo(q.x), bfhi(q.x), bflo(q.y), bfhi(q.y)}, k1 = (f32x4){bflo(q.z), bfhi(q.z), bflo(q.w), bfhi(q.w)}; C0 = (C0 + k0) * eg[c]; C1 = (C1 + k1) * eg[c]; } } } }
    { LAS float* np = (LAS float*)F.lds;
      const float* nloc = WSP(float, WS_NLOC); const bf16_t* qs = WSP(const bf16_t, WS_QS); float* di = WSP(float, WS_DENINTER);
      for (int un = F.vcu; un < BATCH * NCH * 4; un += F.G) { const int b = un >> 6, c = (un >> 2) & 15, qt = un & 3;
          for (int i = tid; i < 1024; i += NTHR) { const int h = i >> 8, d = i & 255, bh = b * MH + h; float nl[NCH - 1], eg[NCH - 1];
#pragma unroll
              for (int cc = 0; cc < NCH - 1; ++cc) { const bool ok = cc < c; nl[cc] = ok ? nloc[(size_t)(bh * NCH + cc) * 256 + d] : 0.f; eg[cc] = ok ? __expf(gc[bh * NCH + cc]) : 1.f; }
              float n = 0.f;
#pragma unroll
              for (int cc = 0; cc < NCH - 1; ++cc) n = (n + nl[cc]) * eg[cc];
              np[i] = n; }
          __syncthreads();
          u32x4 qa[8], qb[8];
#pragma unroll
          for (int r = 0; r < 8; ++r) { const int l = qt * 64 + F.wave * 8 + r; const bf16_t* qp = qs + ((size_t)((b * MH + (lane >> 4)) * NCH + c) * 256 + l) * 256 + (lane & 15) * 16; qa[r] = *(const GAS u32x4*)qp; qb[r] = *(const GAS u32x4*)(qp + 8); }
          const LAS float* w = np + lane * 16;
#pragma unroll
          for (int r = 0; r < 8; ++r) { const int t = b * SEQ + c * LC + qt * 64 + F.wave * 8 + r; const u32x4 a = qa[r], bq = qb[r];
              float s = bflo(a.x) * w[0] + bfhi(a.x) * w[1] + bflo(a.y) * w[2] + bfhi(a.y) * w[3] + bflo(a.z) * w[4] + bfhi(a.z) * w[5] + bflo(a.w) * w[6] + bfhi(a.w) * w[7]
                      + bflo(bq.x) * w[8] + bfhi(bq.x) * w[9] + bflo(bq.y) * w[10] + bfhi(bq.y) * w[11] + bflo(bq.z) * w[12] + bfhi(bq.z) * w[13] + bflo(bq.w) * w[14] + bfhi(bq.w) * w[15];
              s += __shfl_xor(s, 1); s += __shfl_xor(s, 2); s += __shfl_xor(s, 4); s += __shfl_xor(s, 8);
              if ((lane & 15) == 0) wt4f(ws_base_, di + (size_t)t * 4 + (lane >> 4), s); }
          __syncthreads(); } }
}

struct ProbO {
    static constexpr int EPI_VM = 0; static constexpr bool PERM = true, AFTER_DRAIN = true, ALIGN = false, HAS_MID = false, GATHER = false; static constexpr int NSEG = 2; static constexpr unsigned lda0 = 512u, lda1 = 512u, ldb0 = 512u, ldb1 = 512u;
    int nt, ksw, mid_kt; int idx; unsigned char* ws; const float* gn_m;
    __device__ __forceinline__ bool next(int i, Unit& u) const { if (i > 0) return false; u.pm = idx >> 4; u.pn = idx & 15; u.ex = 0; return true; }
    __device__ __forceinline__ void src(const Unit& u, USrc& s) const {
        const int b = u.pm >> 2, h = u.pm & 3;
        s.a0 = (const char*)(ws + WS_P) + ((size_t)u.pm * SEQ + u.pn * LC) * 512;
        s.a1 = (const char*)(ws + WS_QS) + (size_t)(u.pm * NCH + u.pn) * 65536 * 2;
        s.b0 = (const char*)(ws + WS_VT) + (size_t)(u.pm * NCH + u.pn) * 65536 * 2;
        s.b1 = (const char*)(ws + WS_CPT) + (size_t)(u.pm * NCH + u.pn) * 65536 * 2;
    }
    __device__ __forceinline__ void fused(Acc& acc, const Unit& u, int wr, int wc, int fr, int fq, LAS unsigned char* lds, int wid, int lane) const { asm volatile("" : "+v"(fr), "+v"(fq)); const unsigned char* ws_base_ = ws; (void)ws_base_;
        const int b = u.pm >> 2, h = u.pm & 3, t0 = b * SEQ + u.pn * LC;
        const float* dp = (const float*)(ws + WS_DENPART); const float* di = (const float*)(ws + WS_DENINTER);
        LAS f32x2* Pst = (LAS f32x2*)lds;
        { f32x4 d4[2][4]; float dv[2][4];
#pragma unroll
          for (int ai = 0; ai < 2; ++ai)
#pragma unroll
            for (int m = 0; m < 4; ++m) { const size_t to = (size_t)(t0 + ai * 128 + wr * 64 + m * 16 + fr) * 4 + h; d4[ai][m] = *(const GAS f32x4*)(dp + to * 4); dv[ai][m] = di[to]; }
#pragma unroll
          for (int ai = 0; ai < 2; ++ai)
#pragma unroll
            for (int m = 0; m < 4; ++m) { const int l = ai * 128 + wr * 64 + m * 16 + fr;
                const float den = ((d4[ai][m][0] + d4[ai][m][1]) + (d4[ai][m][2] + d4[ai][m][3])) + dv[ai][m];
                const float rd = 1.0f / fmaxf(fabsf(den), 1.0f); float s = 0.f, q = 0.f;
#pragma unroll
                for (int bj = 0; bj < 2; ++bj)
#pragma unroll
                    for (int n = 0; n < 2; ++n) { f32x4 v = acc[ai][bj][m][n] * rd; acc[ai][bj][m][n] = v; s += (v[0] + v[1]) + (v[2] + v[3]); q += (v[0] * v[0] + v[1] * v[1]) + (v[2] * v[2] + v[3] * v[3]); }
                s += __shfl_xor(s, 16); s += __shfl_xor(s, 32); q += __shfl_xor(q, 16); q += __shfl_xor(q, 32);
                if (fq == 0) Pst[l * 4 + wc] = (f32x2){s, q}; } }
        asm volatile("s_waitcnt lgkmcnt(0)" ::: "memory"); __builtin_amdgcn_s_barrier(); asm volatile("" ::: "memory");
        const bf16_t* so = (const bf16_t*)(ws + WS_SO); bf16_t* hm = (bf16_t*)(ws + WS_HM);
        f32x4 gn[2][2];
#pragma unroll
        for (int bj = 0; bj < 2; ++bj) { const float* gp_ = gn_m + h * DH + bj * 128 + wc * 32 + 8 * fq; gn[bj][0] = *(const GAS f32x4*)gp_; gn[bj][1] = *(const GAS f32x4*)(gp_ + 4); }
        u32x4 gs[2][4][2];
#pragma unroll
        for (int ai = 0; ai < 2; ++ai)
#pragma unroll
            for (int m = 0; m < 4; ++m)
#pragma unroll
                for (int bj = 0; bj < 2; ++bj) gs[ai][m][bj] = *(const GAS u32x4*)(so + (size_t)(t0 + ai * 128 + wr * 64 + m * 16 + fr) * MW + h * DH + bj * 128 + wc * 32 + 8 * fq);
#pragma unroll
        for (int ai = 0; ai < 2; ++ai) {
#pragma unroll
            for (int m = 0; m < 4; ++m) { const int l = ai * 128 + wr * 64 + m * 16 + fr;
                const f32x2 p0 = Pst[l * 4 + 0], p1 = Pst[l * 4 + 1], p2 = Pst[l * 4 + 2], p3 = Pst[l * 4 + 3];
                const float mu = ((p0.x + p1.x) + (p2.x + p3.x)) * (1.0f / 256.0f), var = fmaxf(((p0.y + p1.y) + (p2.y + p3.y)) * (1.0f / 256.0f) - mu * mu, 0.f), rstd = 1.0f / sqrtf(var + EPS);
#pragma unroll
                for (int bj = 0; bj < 2; ++bj) { const size_t o = (size_t)(t0 + l) * MW + h * DH + bj * 128 + wc * 32 + 8 * fq; const u32x4 g = gs[ai][m][bj];
                    f32x4 v0 = (acc[ai][bj][m][0] - mu) * rstd * gn[bj][0], v1 = (acc[ai][bj][m][1] - mu) * rstd * gn[bj][1];
                    v0[0] *= bflo(g.x); v0[1] *= bfhi(g.x); v0[2] *= bflo(g.y); v0[3] *= bfhi(g.y); v1[0] *= bflo(g.z); v1[1] *= bfhi(g.z); v1[2] *= bflo(g.w); v1[3] *= bfhi(g.w);
                    wt16(ws_base_, hm + o, pack8(v0, v1)); } }
            asm volatile("" ::: "memory"); }
        asm volatile("s_waitcnt lgkmcnt(0)" ::: "memory"); __builtin_amdgcn_s_barrier(); asm volatile("" ::: "memory");
    }
    __device__ __forceinline__ void epi(const Acc&, const Unit&, int, int, int, int) const {}
};

struct ProbG23 {
    static constexpr int EPI_VM = 16; static constexpr bool PERM = true, AFTER_DRAIN = false, ALIGN = true, HAS_MID = true, GATHER = false; static constexpr int NSEG = 2; static constexpr unsigned lda0 = 2048u, lda1 = 2048u, ldb0 = 4096u, ldb1 = 4096u;
    int nt, ksw, mid_kt; eng::StaticOrder S; unsigned char* ws;
    __device__ __forceinline__ bool next(int i, Unit& u) const { return S.next(i, u); }
    __device__ __forceinline__ void src(const Unit& u, USrc& s) const {
        s.a0 = (const char*)(ws + WS_HM) + (size_t)u.pm * 256 * 2048; s.a1 = (const char*)(ws + WS_HG) + (size_t)u.pm * 256 * 2048;
        s.b0 = (const char*)(ws + WS_WB) + (size_t)u.pn * 256 * 4096; s.b1 = s.b0 + 2048;
    }
    __device__ __forceinline__ void mid(Acc& acc, u32x2 (&keep)[2][4][2], const Unit& u, int wr, int wc, int fr, int fq) const { asm volatile("" : "+v"(fr), "+v"(fq)); const unsigned char* ws_base_ = ws; (void)ws_base_;
        const unsigned char* gmt = ws + WS_GATES + (size_t)(u.pm * 16 + u.pn) * 65536; const unsigned char* ggt = gmt + (size_t)8 * 65536;
        const bool odd = (fq & 1) != 0; const int lofs = (odd ? 512 : 0) + fr * 32 + (fq & ~1) * 8;
#define U8F(w, j) ((float)(((w) >> (8 * (j))) & 0xffu))
        u32x4 gmLL[2][4], ggLL[2][4];
#pragma unroll
        for (int ai = 0; ai < 2; ++ai)
#pragma unroll
            for (int m = 0; m < 4; ++m) { const int q = ((ai * 2 + wr) * 4 + m) * 4 + wc; gmLL[ai][m] = *(const GAS u32x4*)(gmt + q * 1024 + lofs); ggLL[ai][m] = *(const GAS u32x4*)(ggt + q * 1024 + lofs); }
#pragma unroll
        for (int ai = 0; ai < 2; ++ai) { u32x4 gmL[4], ggL[4];
#pragma unroll
            for (int m = 0; m < 4; ++m) { gmL[m] = gmLL[ai][m]; ggL[m] = ggLL[ai][m]; }
            u32x2 gm[4][2], gg[4][2];
#pragma unroll
            for (int m = 0; m < 4; ++m) {
                { const u32x4 L = gmL[m]; const unsigned sx = odd ? L.x : L.z, sy = odd ? L.y : L.w; const unsigned px = (unsigned)__shfl_xor((int)sx, 16), py = (unsigned)__shfl_xor((int)sy, 16);
                  if (!odd) { gm[m][0] = (u32x2){L.x, L.y}; gm[m][1] = (u32x2){px, py}; } else { gm[m][0] = (u32x2){px, py}; gm[m][1] = (u32x2){L.z, L.w}; } }
                { const u32x4 L = ggL[m]; const unsigned sx = odd ? L.x : L.z, sy = odd ? L.y : L.w; const unsigned px = (unsigned)__shfl_xor((int)sx, 16), py = (unsigned)__shfl_xor((int)sy, 16);
                  if (!odd) { gg[m][0] = (u32x2){L.x, L.y}; gg[m][1] = (u32x2){px, py}; } else { gg[m][0] = (u32x2){px, py}; gg[m][1] = (u32x2){L.z, L.w}; } } }
#pragma unroll
            for (int m = 0; m < 4; ++m)
#pragma unroll
                for (int bj = 0; bj < 2; ++bj) { const u32x2 a = gm[m][bj], c = gg[m][bj]; f32x4 r0, r1;
                    r0[0] = U8F(a.x, 0) * __builtin_amdgcn_rcpf(U8F(c.x, 0)); r0[1] = U8F(a.x, 1) * __builtin_amdgcn_rcpf(U8F(c.x, 1));
                    r0[2] = U8F(a.x, 2) * __builtin_amdgcn_rcpf(U8F(c.x, 2)); r0[3] = U8F(a.x, 3) * __builtin_amdgcn_rcpf(U8F(c.x, 3));
                    r1[0] = U8F(a.y, 0) * __builtin_amdgcn_rcpf(U8F(c.y, 0)); r1[1] = U8F(a.y, 1) * __builtin_amdgcn_rcpf(U8F(c.y, 1));
                    r1[2] = U8F(a.y, 2) * __builtin_amdgcn_rcpf(U8F(c.y, 2)); r1[3] = U8F(a.y, 3) * __builtin_amdgcn_rcpf(U8F(c.y, 3));
                    acc[ai][bj][m][0] *= r0; acc[ai][bj][m][1] *= r1; keep[ai][m][bj] = c; }
            asm volatile("" ::: "memory"); }
    }
    __device__ __forceinline__ void epi(const Acc&, const Unit&, int, int, int, int) const {}
    __device__ __forceinline__ void epi_keep(const Acc& acc, const u32x2 (&gg)[2][4][2], const Unit& u, int wr, int wc, int fr, int fq) const { asm volatile("" : "+v"(fr), "+v"(fq)); const unsigned char* ws_base_ = ws; (void)ws_base_;
        bf16_t* mg = (bf16_t*)(ws + WS_MERGED);
        constexpr float I255 = 1.0f / 255.0f;
#pragma unroll
        for (int ai = 0; ai < 2; ++ai) {
#pragma unroll
            for (int m = 0; m < 4; ++m) { const int row = u.pm * 256 + ai * 128 + wr * 64 + m * 16 + fr; const int col = u.pn * 256 + wc * 32 + 8 * fq;
#pragma unroll
                for (int bj = 0; bj < 2; ++bj) { const u32x2 c = gg[ai][m][bj]; f32x4 v0 = acc[ai][bj][m][0], v1 = acc[ai][bj][m][1];
                    v0[0] *= U8F(c.x, 0) * I255; v0[1] *= U8F(c.x, 1) * I255; v0[2] *= U8F(c.x, 2) * I255; v0[3] *= U8F(c.x, 3) * I255;
                    v1[0] *= U8F(c.y, 0) * I255; v1[1] *= U8F(c.y, 1) * I255; v1[2] *= U8F(c.y, 2) * I255; v1[3] *= U8F(c.y, 3) * I255;
                    wt16(ws_base_, mg + (size_t)row * D + col + bj * 128, pack8(v0, v1)); } }
            asm volatile("" ::: "memory"); }
    }
#undef U8F
};

struct ProbG4 {
    static constexpr int EPI_VM = 16; static constexpr bool PERM = true, AFTER_DRAIN = false, ALIGN = true, HAS_MID = false, GATHER = false; static constexpr int NSEG = 1; static constexpr unsigned lda0 = 4096u, lda1 = 4096u, ldb0 = 4096u, ldb1 = 4096u;
    int nt, ksw, mid_kt; eng::StaticOrder S; unsigned char* ws;
    __device__ __forceinline__ bool next(int i, Unit& u) const { return S.next(i, u); }
    __device__ __forceinline__ void src(const Unit& u, USrc& s) const {
        s.a0 = s.a1 = (const char*)(ws + WS_MERGED) + (size_t)u.pm * 256 * 4096; s.b0 = s.b1 = (const char*)(ws + WS_WOUT) + (size_t)u.pn * 256 * 4096;
    }
    __device__ __forceinline__ void epi(const Acc& acc, const Unit& u, int wr, int wc, int fr, int fq) const { asm volatile("" : "+v"(fr), "+v"(fq)); const unsigned char* ws_base_ = ws; (void)ws_base_;
        bf16_t* dst = (bf16_t*)(ws + WS_MIX);
        const int row0 = u.pm * 256 + wr * 64 + fr, col0 = u.pn * 256 + wc * 32 + 8 * fq;
#pragma unroll
        for (int ai = 0; ai < 2; ++ai)
#pragma unroll
            for (int m = 0; m < 4; ++m) { bf16_t* rowp = dst + (size_t)(row0 + ai * 128 + m * 16) * D + col0;
#pragma unroll
                for (int bj = 0; bj < 2; ++bj) wt16(ws_base_, rowp + bj * 128, pack8(acc[ai][bj][m][0], acc[ai][bj][m][1])); }
    }
};

__device__ __forceinline__ void p8_router(Frame& F, const Args& args) {
    const unsigned char* ws_base_ = F.ws;
    DECL_TID;
    const float* g_ffn = INP(15);
    { LAS float* scr = (LAS float*)(F.lds + F.wave * TSCR_BYTES);
      const int gw = F.vcu * NWAVES + F.wave, NGW = F.G * NWAVES;
      constexpr int I_13 = 32 * 32 * 16, I_2 = 32 * 8 * 32;
      const int sl = lane & 15, grp2 = sl >> 3, isw3 = (sl >> 2) & 1, c4 = (sl & 3) * 4;
      auto mk = [&](int it) { CItem I;
          if (it < I_13) { const int e = it >> 9, r = it & 511, kb = r & 31, nb = r >> 5;
              I.slp = (isw3 ? INP(21) : INP(20)) + (size_t)e * D * DE + (nb * 2 + grp2) * 16 + c4; I.srcld = DE; I.ksc = g_ffn; I.k0 = kb * 64; I.dst = WSP(bf16_t, WS_W13) + ((size_t)e * 1024 + nb * 64) * D + kb * 64; I.dstld = D; }
          else { const int r2 = it - I_13, e = r2 >> 8, r = r2 & 255, kb = r & 7, nb = r >> 3;
              I.slp = INP(22) + (size_t)e * DE * D + nb * 64 + (lane & 15) * 4; I.srcld = D; I.ksc = nullptr; I.k0 = kb * 64; I.dst = WSP(bf16_t, WS_W2) + ((size_t)e * D + nb * 64) * DE + kb * 64; I.dstld = DE; }
          return I; };
      f32x4 v[16]; float scl[16]; CItem cur, nxt;
      if (gw < I_13 + I_2) { cur = mk(gw); citem_load(v, scl, cur, lane); }
      asm volatile("" ::: "memory");
#pragma unroll 1
      for (int it = gw; it < I_13 + I_2; it += NGW) {
          const bool hn = it + NGW < I_13 + I_2; if (hn) nxt = mk(it + NGW);
          citem_to_lds(v, scl, scr, lane);
          if (hn) citem_load(v, scl, nxt, lane);
          asm volatile("" ::: "memory");
          citem_emit(F.ws, cur, scr, lane);
          cur = nxt;
      } }
    __syncthreads();
    LAS bf16_t* we = (LAS bf16_t*)F.lds;
    { const float* w_re = INP(18);
      for (int idx = tid; idx < D * 32 / 2; idx += NTHR) { const int k = idx >> 4, e2 = (idx & 15) * 2; const float g = g_ffn[k];
          const f32x2 w = *(const GAS f32x2*)(w_re + (size_t)k * 32 + e2); we[e2 * D + k] = (bf16_t)f2bf(w.x * g); we[(e2 + 1) * D + k] = (bf16_t)f2bf(w.y * g); } }
    LAS int* s_e = (LAS int*)(F.lds + XTR_OFF);
    LAS float* s_w = (LAS float*)(F.lds + XTR_OFF + 512);
    LAS int* s_cnt = (LAS int*)(F.lds + XTR_OFF + 1024);
    LAS int* s_base = s_cnt + 32;
    LAS int* s_rank = s_cnt + 64;
    LAS bf16_t* wgl = (LAS bf16_t*)(F.lds + XTR_OFF + 4096);
    { const float* w_rg = INP(16);
      for (int k = tid; k < D; k += NTHR) { const f32x4 w = *(const GAS f32x4*)(w_rg + (size_t)k * 4); const float g = g_ffn[k];
          wgl[0 * D + k] = (bf16_t)f2bf(w[0] * g); wgl[1 * D + k] = (bf16_t)f2bf(w[1] * g); wgl[2 * D + k] = (bf16_t)f2bf(w[2] * g); wgl[3 * D + k] = (bf16_t)f2bf(w[3] * g); } }
    const float* b_rg = INP(17); const float* b_re = INP(19);
    const float* xin = INP(0); const bf16_t* mix = WSP(const bf16_t, WS_MIX); bf16_t* x1b = WSP(bf16_t, WS_X1B);
    for (int blk = F.vcu; blk < M / 64; blk += F.G) {
        if (tid < 32) s_cnt[tid] = 0;
        __syncthreads();
        f32x4 nx[8]; u32x4 nm[4];
        { const int t = blk * 64 + F.wave * 8; const float* xrow = xin + (size_t)t * D; const bf16_t* mrow = mix + (size_t)t * D;
#pragma unroll
          for (int p = 0; p < 4; ++p) { nm[p] = *(const GAS u32x4*)(mrow + 512 * p + 8 * lane); nx[2 * p] = *(const GAS f32x4*)(xrow + E0(2 * p)); nx[2 * p + 1] = *(const GAS f32x4*)(xrow + E0(2 * p + 1)); } }
#pragma unroll 1
        for (int r = 0; r < 8; ++r) { const int tl = F.wave * 8 + r, t = blk * 64 + tl;
            bf16_t* xbrow = x1b + (size_t)t * D;
            f32x4 v[8]; float ss = 0.f, g0 = 0.f, g1 = 0.f, g2 = 0.f, g3 = 0.f;
#pragma unroll
            for (int p = 0; p < 4; ++p) { const u32x4 mm = nm[p]; f32x4 a = nx[2 * p], b = nx[2 * p + 1];
                a[0] += bflo(mm.x); a[1] += bfhi(mm.x); a[2] += bflo(mm.y); a[3] += bfhi(mm.y); b[0] += bflo(mm.z); b[1] += bfhi(mm.z); b[2] += bflo(mm.w); b[3] += bfhi(mm.w);
                v[2 * p] = a; v[2 * p + 1] = b; }
            if (r < 7) { const float* xrow = xin + (size_t)(t + 1) * D; const bf16_t* mrow = mix + (size_t)(t + 1) * D;
#pragma unroll
                for (int p = 0; p < 4; ++p) { nm[p] = *(const GAS u32x4*)(mrow + 512 * p + 8 * lane); nx[2 * p] = *(const GAS f32x4*)(xrow + E0(2 * p)); nx[2 * p + 1] = *(const GAS f32x4*)(xrow + E0(2 * p + 1)); } }
#pragma unroll
            for (int j = 0; j < 8; ++j) ss += (v[j][0] * v[j][0] + v[j][1] * v[j][1]) + (v[j][2] * v[j][2] + v[j][3] * v[j][3]);
            float gacc[4];
#pragma unroll
            for (int g = 0; g < 4; ++g) { const LAS bf16_t* wp = wgl + g * D + 8 * lane; float a = 0.f;
#pragma unroll
                for (int p = 0; p < 4; ++p) { const u32x4 w = *(const LAS u32x4*)(wp + 512 * p); a += ((v[2 * p][0] * bflo(w.x) + v[2 * p][1] * bfhi(w.x)) + (v[2 * p][2] * bflo(w.y) + v[2 * p][3] * bfhi(w.y))) + ((v[2 * p + 1][0] * bflo(w.z) + v[2 * p + 1][1] * bfhi(w.z)) + (v[2 * p + 1][2] * bflo(w.w) + v[2 * p + 1][3] * bfhi(w.w))); }
                gacc[g] = a; }
            g0 = gacc[0]; g1 = gacc[1]; g2 = gacc[2]; g3 = gacc[3];
            ss = wave_sum(ss); g0 = wave_sum(g0); g1 = wave_sum(g1); g2 = wave_sum(g2); g3 = wave_sum(g3);
            const float rr = 1.0f / sqrtf(ss * (1.0f / D) + EPS);
#pragma unroll
            for (int p = 0; p < 4; ++p) wt16(ws_base_, xbrow + 512 * p + 8 * lane, pack8(v[2 * p] * rr, v[2 * p + 1] * rr));
            float gl[4] = {rr * g0 + b_rg[0], rr * g1 + b_rg[1], rr * g2 + b_rg[2], rr * g3 + b_rg[3]};
            int grp = 0; float gmax = gl[0];
#pragma unroll
            for (int g = 1; g < 4; ++g) if (gl[g] > gmax) { gmax = gl[g]; grp = g; }
            const float pg = 1.0f / ((__expf(gl[0] - gmax) + __expf(gl[1] - gmax)) + (__expf(gl[2] - gmax) + __expf(gl[3] - gmax)));
            float el[8];
#pragma unroll
            for (int e = 0; e < 8; ++e) { const LAS bf16_t* wp = we + (size_t)(grp * 8 + e) * D + 8 * lane; float a = 0.f;
#pragma unroll
                for (int p = 0; p < 4; ++p) { const u32x4 w = *(const LAS u32x4*)(wp + 512 * p); a += ((v[2 * p][0] * bflo(w.x) + v[2 * p][1] * bfhi(w.x)) + (v[2 * p][2] * bflo(w.y) + v[2 * p][3] * bfhi(w.y))) + ((v[2 * p + 1][0] * bflo(w.z) + v[2 * p + 1][1] * bfhi(w.z)) + (v[2 * p + 1][2] * bflo(w.w) + v[2 * p + 1][3] * bfhi(w.w))); }
                el[e] = rr * wave_sum(a) + b_re[grp * 8 + e]; }
            int i0 = 0; float m0 = el[0];
#pragma unroll
            for (int e = 1; e < 8; ++e) if (el[e] > m0) { m0 = el[e]; i0 = e; }
            int i1 = -1; float m1 = -3.0e38f;
#pragma unroll
            for (int e = 0; e < 8; ++e) if (e != i0 && el[e] > m1) { m1 = el[e]; i1 = e; }
            const float e1 = __expf(m1 - m0), w0 = pg / (1.0f + e1), w1 = pg * e1 / (1.0f + e1);
            if (lane == 0) { s_e[tl * 2] = grp * 8 + i0; s_e[tl * 2 + 1] = grp * 8 + i1; s_w[tl * 2] = w0; s_w[tl * 2 + 1] = w1; wt4f(ws_base_, WSP(float, WS_R1) + t, rr); }
        }
        __syncthreads();
        if (tid < 128) s_rank[tid] = atomicAdd((int*)&s_cnt[s_e[tid]], 1);
        __syncthreads();
        { const int t2 = F.wave * 64 + lane_id();
          if (t2 < 32) { const int c = s_cnt[t2]; s_base[t2] = c > 0 ? (int)__hip_atomic_fetch_add((unsigned*)(F.ctl + CW_CNT + 64 * t2), (unsigned)c, RLX_AGENT) : 0; } }
        __syncthreads();
        if (tid < 128) { const int e = s_e[tid], pos = s_base[e] + s_rank[tid]; wt4(ws_base_, WSP(int, WS_LIST) + (size_t)e * M + pos, (unsigned)((blk * 64 + (tid >> 1)) * 2 + (tid & 1))); wt4f(ws_base_, WSP(float, WS_LISTW) + (size_t)e * M + pos, s_w[tid]); }
        __syncthreads();
    }
}

__device__ __forceinline__ void moe_table(Frame& F, LAS int* tstart, LAS int* cnt) {
    DECL_TID;
    if (tid < 32) cnt[tid] = (int)__hip_atomic_load((unsigned*)(F.ctl + CW_CNT + 64 * tid), RLX_AGENT);
    __syncthreads();
    if (tid == 0) { int a = 0; for (int e = 0; e < 32; ++e) { tstart[e] = a; a += (cnt[e] + 255) >> 8; } tstart[32] = a; }
    __syncthreads();
}
__device__ __forceinline__ int moe_expert_of(const LAS int* tstart, int rt) { int e = 0; while (e < 31 && tstart[e + 1] <= rt) ++e; return e; }

struct ProbMU {
    static constexpr int EPI_VM = 8; static constexpr bool PERM = false, AFTER_DRAIN = false, ALIGN = true, HAS_MID = false, GATHER = true; static constexpr int NSEG = 1; static constexpr unsigned lda0 = 4096u, lda1 = 4096u, ldb0 = 4096u, ldb1 = 4096u;
    int nt, ksw, mid_kt; int G, c0, nun; unsigned char* ws; const LAS int* tstart; const LAS int* cnt;
    __device__ __forceinline__ bool next(int i, Unit& u) const { const int idx = i * G + c0; if (idx >= nun) return false;
        u.pm = idx >> 2; u.pn = idx & 3; u.ex = __builtin_amdgcn_readfirstlane(moe_expert_of(tstart, u.pm)); return true; }
    __device__ __forceinline__ void src(const Unit& u, USrc& s) const {
        s.a0 = s.a1 = (const char*)(ws + WS_X1B);
        s.b0 = s.b1 = (const char*)(ws + WS_W13) + ((size_t)u.ex * 1024 + u.pn * 256) * 4096;
    }
    __device__ __forceinline__ int tok_of(const Unit& u, int r) const { const int pos = (u.pm - __builtin_amdgcn_readfirstlane(tstart[u.ex])) * 256 + r;
        return pos < __builtin_amdgcn_readfirstlane(cnt[u.ex]) ? (((const int*)(ws + WS_LIST))[(size_t)u.ex * M + pos] >> 1) : 0; }
    __device__ __forceinline__ unsigned arow(const Unit& u, int r) const { return (unsigned)tok_of(u, r) * 4096u; }
    __device__ __forceinline__ void epi(const Acc& acc, const Unit& u, int wr, int wc, int fr, int fq) const { asm volatile("" : "+v"(fr), "+v"(fq)); const unsigned char* ws_base_ = ws; (void)ws_base_;
        bf16_t* H = (bf16_t*)(ws + WS_H);
#pragma unroll
        for (int ai = 0; ai < 2; ++ai)
#pragma unroll
            for (int m = 0; m < 4; ++m) { const int r = ai * 128 + wr * 64 + m * 16 + fr;
                u32x2 w0, w1;
                { const f32x4 a = acc[ai][0][m][0], bq = acc[ai][0][m][1]; w0.x = cvt_pk_bf16(fsilu(a[0]) * bq[0], fsilu(a[1]) * bq[1]); w0.y = cvt_pk_bf16(fsilu(a[2]) * bq[2], fsilu(a[3]) * bq[3]); }
                { const f32x4 a = acc[ai][1][m][0], bq = acc[ai][1][m][1]; w1.x = cvt_pk_bf16(fsilu(a[0]) * bq[0], fsilu(a[1]) * bq[1]); w1.y = cvt_pk_bf16(fsilu(a[2]) * bq[2], fsilu(a[3]) * bq[3]); }
                const bool odd = (fq & 1) != 0;
                const unsigned sx = odd ? w0.x : w1.x, sy = odd ? w0.y : w1.y;
                const unsigned px = (unsigned)__shfl_xor((int)sx, 16), py = (unsigned)__shfl_xor((int)sy, 16);
                u32x4 o; if (!odd) { o.x = w0.x; o.y = w0.y; o.z = px; o.w = py; } else { o.x = px; o.y = py; o.z = w1.x; o.w = w1.y; }
                bf16_t* rowp = H + (size_t)(u.pm * 256 + r) * DE + u.pn * 128 + wc * 16 + 4 * (fq & ~1) + (odd ? 64 : 0);
                wt16(ws_base_, rowp, o); if (m & 1) asm volatile("" ::: "memory"); }
    }
};
struct ProbMD {
    static constexpr int EPI_VM = 16; static constexpr bool PERM = true, AFTER_DRAIN = false, ALIGN = true, HAS_MID = false, GATHER = false; static constexpr int NSEG = 1; static constexpr unsigned lda0 = 1024u, lda1 = 1024u, ldb0 = 1024u, ldb1 = 1024u;
    int nt, ksw, mid_kt; int G, c0; unsigned char* ws; const LAS int* tstart; const LAS int* cnt;
    __device__ __forceinline__ bool next(int i, Unit& u) const { const int idx = i * G + c0; if (idx >= __builtin_amdgcn_readfirstlane(tstart[32]) * 8) return false;
        const int rt = idx >> 3; u.pm = rt; u.pn = idx & 7; u.ex = __builtin_amdgcn_readfirstlane(moe_expert_of(tstart, rt)); return true; }
    __device__ __forceinline__ void src(const Unit& u, USrc& s) const {
        s.a0 = s.a1 = (const char*)(ws + WS_H) + (size_t)u.pm * 256 * 1024;
        s.b0 = s.b1 = (const char*)(ws + WS_W2) + ((size_t)u.ex * D + u.pn * 256) * 1024;
    }
    __device__ __forceinline__ void epi(const Acc& acc, const Unit& u, int wr, int wc, int fr, int fq) const { asm volatile("" : "+v"(fr), "+v"(fq)); const unsigned char* ws_base_ = ws; (void)ws_base_;
        bf16_t* Y = (bf16_t*)(ws + WS_Y); const int* list = (const int*)(ws + WS_LIST); const float* lw = (const float*)(ws + WS_LISTW);
        const int j = u.pm - __builtin_amdgcn_readfirstlane(tstart[u.ex]), n = __builtin_amdgcn_readfirstlane(cnt[u.ex]);
        int t2[2][4]; float wv[2][4];
#pragma unroll
        for (int ai = 0; ai < 2; ++ai)
#pragma unroll
            for (int m = 0; m < 4; ++m) { const int pos = j * 256 + ai * 128 + wr * 64 + m * 16 + fr; const bool ok = pos < n;
                t2[ai][m] = ok ? list[(size_t)u.ex * M + pos] : -1; wv[ai][m] = ok ? lw[(size_t)u.ex * M + pos] : 0.f; }
#pragma unroll
        for (int ai = 0; ai < 2; ++ai)
#pragma unroll
            for (int m = 0; m < 4; ++m) {
                const bool ok = t2[ai][m] >= 0; const float w = wv[ai][m];
                bf16_t* rowp = ok ? Y + (size_t)t2[ai][m] * D + u.pn * 256 + wc * 32 + 8 * fq : (bf16_t*)(ws + WS_DUMP) + ((wr * 4 + wc) * 64 + fq * 16 + fr) * 8;
                const int bjs = ok ? 128 : 4096;
#pragma unroll
                for (int bj = 0; bj < 2; ++bj) wt16(ws_base_, rowp + bj * bjs, pack8(acc[ai][bj][m][0] * w, acc[ai][bj][m][1] * w)); }
    }
};

__device__ __forceinline__ void p11_combine(Frame& F) {
    const unsigned char* ws_base_ = F.ws;
    DECL_TID; const int gw = F.vcu * NWAVES + F.wave, NGW = F.G * NWAVES;
    const bf16_t* Y = WSP(const bf16_t, WS_Y); bf16_t* xb = WSP(bf16_t, WS_X1B); float* r2 = WSP(float, WS_R2); const float* r1 = WSP(const float, WS_R1);
    for (int m = gw; m < M; m += NGW) { const float q = 1.0f / r1[m];
        const bf16_t* y0 = Y + (size_t)(2 * m) * D + 8 * lane; const bf16_t* y1 = Y + (size_t)(2 * m + 1) * D + 8 * lane; bf16_t* ob = xb + (size_t)m * D + 8 * lane;
        float ss = 0.f;
#pragma unroll
        for (int p = 0; p < 4; ++p) { const u32x4 x = *(const GAS u32x4*)(ob + 512 * p), a = *(const GAS u32x4*)(y0 + 512 * p), b = *(const GAS u32x4*)(y1 + 512 * p); f32x4 v0, v1;
            v0[0] = bflo(x.x) * q + (bflo(a.x) + bflo(b.x)); v0[1] = bfhi(x.x) * q + (bfhi(a.x) + bfhi(b.x)); v0[2] = bflo(x.y) * q + (bflo(a.y) + bflo(b.y)); v0[3] = bfhi(x.y) * q + (bfhi(a.y) + bfhi(b.y));
            v1[0] = bflo(x.z) * q + (bflo(a.z) + bflo(b.z)); v1[1] = bfhi(x.z) * q + (bfhi(a.z) + bfhi(b.z)); v1[2] = bflo(x.w) * q + (bflo(a.w) + bflo(b.w)); v1[3] = bfhi(x.w) * q + (bfhi(a.w) + bfhi(b.w));
            wt16(ws_base_, ob + 512 * p, pack8(v0, v1));
            ss += ((v0[0] * v0[0] + v0[1] * v0[1]) + (v0[2] * v0[2] + v0[3] * v0[3])) + ((v1[0] * v1[0] + v1[1] * v1[1]) + (v1[2] * v1[2] + v1[3] * v1[3])); }
        ss = wave_sum(ss);
        if (lane == 0) wt4f(ws_base_, r2 + m, 1.0f / sqrtf(ss * (1.0f / D) + EPS));
    }
}

struct ProbPG {
    static constexpr int EPI_VM = 16; static constexpr bool PERM = true, AFTER_DRAIN = false, ALIGN = true, HAS_MID = false, GATHER = false; static constexpr int NSEG = 1; static constexpr unsigned lda0 = 4096u, lda1 = 4096u, ldb0 = 4096u, ldb1 = 4096u;
    int nt, ksw, mid_kt; eng::StaticOrder S; unsigned char* ws;
    __device__ __forceinline__ bool next(int i, Unit& u) const { return S.next(i, u); }
    __device__ __forceinline__ void src(const Unit& u, USrc& s) const {
        s.a0 = s.a1 = (const char*)(ws + WS_X1B) + (size_t)u.pm * 256 * 4096; s.b0 = s.b1 = (const char*)(ws + WS_WPG) + (size_t)u.pn * 256 * 4096;
    }
    __device__ __forceinline__ void epi(const Acc& acc, const Unit& u, int wr, int wc, int fr, int fq) const { asm volatile("" : "+v"(fr), "+v"(fq)); const unsigned char* ws_base_ = ws; (void)ws_base_;
        const float* r2 = (const float*)(ws + WS_R2); const bf16_t* ple = (const bf16_t*)(ws + WS_PLEV) + (size_t)(u.pm * 8 + u.pn) * 65536 + fr * 32 + fq * 8; bf16_t* gp = (bf16_t*)(ws + WS_GP);
        u32x4 pv[2][4][2]; float rs[2][4];
#pragma unroll
        for (int ai = 0; ai < 2; ++ai)
#pragma unroll
            for (int m = 0; m < 4; ++m) { const int row = u.pm * 256 + ai * 128 + wr * 64 + m * 16 + fr; rs[ai][m] = r2[row];
#pragma unroll
                for (int bj = 0; bj < 2; ++bj) pv[ai][m][bj] = *(const GAS u32x4*)(ple + ((((ai * 2 + wr) * 4 + m) * 4 + wc) * 2 + bj) * 512); }
#pragma unroll
        for (int ai = 0; ai < 2; ++ai) {
#pragma unroll
            for (int m = 0; m < 4; ++m) { const size_t ro = (size_t)(u.pm * 256 + ai * 128 + wr * 64 + m * 16 + fr) * D + u.pn * 256 + wc * 32 + 8 * fq;
#pragma unroll
                for (int bj = 0; bj < 2; ++bj) { const u32x4 p = pv[ai][m][bj]; f32x4 v0 = act4<1>(acc[ai][bj][m][0] * rs[ai][m]), v1 = act4<1>(acc[ai][bj][m][1] * rs[ai][m]);
                    v0[0] *= bflo(p.x); v0[1] *= bfhi(p.x); v0[2] *= bflo(p.y); v0[3] *= bfhi(p.y); v1[0] *= bflo(p.z); v1[1] *= bfhi(p.z); v1[2] *= bflo(p.w); v1[3] *= bfhi(p.w);
                    wt16(ws_base_, gp + ro + bj * 128, pack8(v0, v1)); } }
            asm volatile("" ::: "memory"); }
    }
};

__device__ __forceinline__ void p13_final(Frame& F, const Args& args) {
    DECL_TID; const int gw = F.vcu * NWAVES + F.wave, NGW = F.G * NWAVES;
    const bf16_t* gp = WSP(const bf16_t, WS_GP); const float* gf = INP(26);
    f32x4 g[8];
#pragma unroll
    for (int j = 0; j < 8; ++j) g[j] = *(const GAS f32x4*)(gf + E0(j));
    for (int m = gw; m < M; m += NGW) {
        float* orow = F.out + (size_t)m * D; const bf16_t* pr = gp + (size_t)m * D + 8 * lane; const bf16_t* xq = WSP(const bf16_t, WS_X1B) + (size_t)m * D + 8 * lane;
        f32x4 v[8]; float ss = 0.f;
#pragma unroll
        for (int p = 0; p < 4; ++p) { const u32x4 a = *(const GAS u32x4*)(pr + 512 * p), x = *(const GAS u32x4*)(xq + 512 * p);
            v[2 * p][0] = bflo(x.x) + bflo(a.x); v[2 * p][1] = bfhi(x.x) + bfhi(a.x); v[2 * p][2] = bflo(x.y) + bflo(a.y); v[2 * p][3] = bfhi(x.y) + bfhi(a.y);
            v[2 * p + 1][0] = bflo(x.z) + bflo(a.z); v[2 * p + 1][1] = bfhi(x.z) + bfhi(a.z); v[2 * p + 1][2] = bflo(x.w) + bflo(a.w); v[2 * p + 1][3] = bfhi(x.w) + bfhi(a.w); }
#pragma unroll
        for (int j = 0; j < 8; ++j) ss += (v[j][0] * v[j][0] + v[j][1] * v[j][1]) + (v[j][2] * v[j][2] + v[j][3] * v[j][3]);
        ss = wave_sum(ss);
        const float r = 1.0f / sqrtf(ss * (1.0f / D) + EPS);
#pragma unroll
        for (int j = 0; j < 8; ++j) *(GAS f32x4*)(orow + E0(j)) = v[j] * r * g[j];
    }
}

__global__ void __launch_bounds__(NTHR, 2) mk_fwd(Args args) {
    extern __shared__ __attribute__((aligned(16))) unsigned char lds[];
    Frame F;
    F.lds = (LAS unsigned char*)lds;
    F.MISC = (volatile LAS unsigned*)(F.lds + MISC_OFF);
    F.wave = __builtin_amdgcn_readfirstlane((int)threadIdx.x >> 6);
    F.G = gridDim.x; { const int bx = blockIdx.x; F.vcu = (F.G % 8 == 0) ? (bx % 8) * (F.G / 8) + bx / 8 : bx; }
    F.ws = args.ws; F.out = args.out; F.ctl = (gu32*)(args.ws + WS_CTL);
    for (int u = (int)threadIdx.x; u < (LDS_BYTES - LDSCTL_OFF) / 4; u += NTHR) ((LAS unsigned*)(F.lds + LDSCTL_OFF))[u] = 0u;
    __syncthreads();
    XcdBarrier bar; bar.bar = (unsigned*)(F.ctl + CW_BAR); bar.x = 0; bar.st = nullptr;
    if (N_LAUNCHES == 1) bar = xcd_barrier_post((unsigned*)(F.ctl + CW_BAR), F.MISC + 8);
    const int lo = args.ph_lo, hi = args.ph_hi;
#define IN(k) (((PHASE_MASK >> (k)) & 1) && lo <= (k) && (k) < hi)
#define SEAM(k) do { if (IN(k) && IN((k) + 1)) xcd_barrier(bar); } while (0)
#define REP(k) for (int rep_ = 0; rep_ < (((REPEAT_MASK >> (k)) & 1) ? 2 : 1); ++rep_)
    LAS unsigned char* ring = F.lds;
    const int bx = (int)blockIdx.x;

    REP(0) if (IN(0)) { if (rep_) xcd_barrier(bar); p0_prologue(F, args); } SEAM(0);
    REP(1) if (IN(1)) { if (rep_) xcd_barrier(bar);
        { ProbG1 P; P.nt = 32; P.ksw = 1 << 20; P.mid_kt = -1; P.S.init(M, NG1, F.G, bx); P.ws = F.ws; eng::gemm_phase(ring, P, F.wave); }
        { ProbPU P; P.nt = 4; P.ksw = 1 << 20; P.mid_kt = -1; P.S.init(M, D, F.G, bx); P.ws = F.ws; eng::gemm_phase(ring, P, F.wave); }
    } SEAM(1);
    REP(2) if (IN(2)) { if (rep_) xcd_barrier(bar); p2_elementwise(F, args);
        asm volatile("s_waitcnt vmcnt(0)" ::: "memory"); __syncthreads();
        if (threadIdx.x == 0) { __builtin_amdgcn_fence(__ATOMIC_ACQUIRE, "agent"); asm volatile("s_waitcnt vmcnt(0)" ::: "memory"); }
        __syncthreads();
        { ProbP3 P; P.nt = 4; P.ksw = 1 << 20; P.mid_kt = -1; P.G = F.G; P.c0 = bx; P.mode = 0; P.ws = F.ws; P.b_s = INP(11); eng::gemm_phase(ring, P, F.wave); }
    } SEAM(2);
    REP(3) if (IN(3)) { if (rep_) xcd_barrier(bar);
        { ProbP3 P; P.nt = 4; P.ksw = 1 << 20; P.mid_kt = -1; P.G = F.G; P.c0 = bx; P.mode = 1; P.ws = F.ws; P.b_s = INP(11); eng::gemm_phase(ring, P, F.wave); }
        p4_scan(F);
    } SEAM(3);
    REP(5) if (IN(5)) { if (rep_) xcd_barrier(bar);
        for (int idx = bx; idx < 256; idx += F.G) { ProbO P; P.nt = 8; P.ksw = 4; P.mid_kt = -1; P.idx = idx; P.ws = F.ws; P.gn_m = INP(7); eng::gemm_phase(ring, P, F.wave); }
    } SEAM(5);
    REP(6) if (IN(6)) { if (rep_) xcd_barrier(bar); ProbG23 P; P.nt = 32; P.ksw = 16; P.mid_kt = 16; P.S.init(M, D, F.G, bx); P.ws = F.ws; eng::gemm_phase(ring, P, F.wave); } SEAM(6);
    REP(7) if (IN(7)) { if (rep_) xcd_barrier(bar); ProbG4 P; P.nt = 32; P.ksw = 1 << 20; P.mid_kt = -1; P.S.init(M, D, F.G, bx); P.ws = F.ws; eng::gemm_phase(ring, P, F.wave); } SEAM(7);
    REP(8) if (IN(8)) { if (rep_) xcd_barrier(bar); p8_router(F, args); } SEAM(8);
    LAS int* tstart = (LAS int*)(F.lds + XTR_OFF + 2048); LAS int* tcnt = tstart + 64;
    REP(9) if (IN(9)) { if (rep_) xcd_barrier(bar);
        moe_table(F, tstart, tcnt);
        const int nun = __builtin_amdgcn_readfirstlane(tstart[32]) * 4;
        { ProbMU P; P.nt = 32; P.ksw = 1 << 20; P.mid_kt = -1; P.G = F.G; P.c0 = bx; P.nun = nun; P.ws = F.ws; P.tstart = tstart; P.cnt = tcnt; eng::gemm_phase(ring, P, F.wave); }
    } SEAM(9);
    REP(10) if (IN(10)) { if (rep_) xcd_barrier(bar);
        moe_table(F, tstart, tcnt);
        ProbMD P; P.nt = 8; P.ksw = 1 << 20; P.mid_kt = -1; P.G = F.G; P.c0 = bx; P.ws = F.ws; P.tstart = tstart; P.cnt = tcnt; eng::gemm_phase(ring, P, F.wave);
    } SEAM(10);
    REP(11) if (IN(11)) { if (rep_) xcd_barrier(bar); p11_combine(F); } SEAM(11);
    REP(12) if (IN(12)) { if (rep_) xcd_barrier(bar); ProbPG P; P.nt = 32; P.ksw = 1 << 20; P.mid_kt = -1; P.S.init(M, D, F.G, bx); P.ws = F.ws; eng::gemm_phase(ring, P, F.wave); } SEAM(12);
    REP(13) if (IN(13)) { if (rep_) xcd_barrier(bar); p13_final(F, args); }
#undef IN
#undef SEAM
}

extern "C" void kernel_launch(void* const* d_in, const int* in_sizes, int n_in, void* d_out, int out_size, void* d_ws, size_t ws_size, hipStream_t stream) {
    static int grid = 0;
    if (grid == 0) {
        if (n_in != 27 || out_size != M * D || ws_size < WS_END) { fprintf(stderr, "kernel_launch: unexpected problem (n_in %d, out %d, ws %zu < %zu)\n", n_in, out_size, ws_size, (size_t)WS_END); grid = -1; return; }
        int dev = 0, cus = 0, per_cu = 0;
        if (hipGetDevice(&dev) != hipSuccess || hipDeviceGetAttribute(&cus, hipDeviceAttributeMultiprocessorCount, dev) != hipSuccess) { grid = -1; return; }
        if (hipFuncSetAttribute((const void*)mk_fwd, hipFuncAttributeMaxDynamicSharedMemorySize, LDS_BYTES) != hipSuccess) { fprintf(stderr, "kernel_launch: hipFuncSetAttribute failed\n"); grid = -1; return; }
        if (hipOccupancyMaxActiveBlocksPerMultiprocessor(&per_cu, (const void*)mk_fwd, NTHR, LDS_BYTES) != hipSuccess || per_cu < 1) fprintf(stderr, "kernel_launch: occupancy query reports %d\n", per_cu);
        (void)hipGetLastError();
        grid = cus;
    }
    if (grid < 0) return;
    (void)hipMemsetAsync((char*)d_ws + WS_CTL, 0, CTL_ZERO_BYTES, stream);
    Args a{};
    for (int i = 0; i < 27; ++i) a.in[i] = (const float*)d_in[i];
    a.out = (float*)d_out; a.ws = (unsigned char*)d_ws;
    if (N_LAUNCHES == 1) { a.ph_lo = 0; a.ph_hi = NPHASE; hipLaunchKernelGGL(mk_fwd, dim3(grid), dim3(NTHR), LDS_BYTES, stream, a); }
    else { for (int p = 0; p < NPHASE; ++p) { a.ph_lo = p; a.ph_hi = p + 1; hipLaunchKernelGGL(mk_fwd, dim3(grid), dim3(NTHR), LDS_BYTES, stream, a); } }
}
```

```cpp
#include <hip/hip_runtime.h>
#include <cstdio>
#include <cstdint>

#define LAS __attribute__((address_space(3)))
#define GAS __attribute__((address_space(1)))
typedef unsigned short bf16_t;
typedef short bf16x8 __attribute__((ext_vector_type(8)));
typedef float f32x4 __attribute__((ext_vector_type(4)));
typedef float f32x2 __attribute__((ext_vector_type(2)));
typedef unsigned u32x4 __attribute__((ext_vector_type(4)));
typedef unsigned u32x2 __attribute__((ext_vector_type(2)));
typedef GAS unsigned gu32;

#ifndef MK_N_LAUNCHES
#define MK_N_LAUNCHES 1
#endif
constexpr int NPHASE = 14;
constexpr int N_LAUNCHES = MK_N_LAUNCHES;
#ifndef PHASE_MASK
#define PHASE_MASK 0x3fff
#endif
#ifndef REPEAT_MASK
#define REPEAT_MASK 0
#endif

constexpr int D = 2048, BATCH = 4, SEQ = 4096, M = BATCH * SEQ;
constexpr int MW = 1024, MH = 4, DH = 256, GW = 1024, NEXP = 32, DE = 512, PLE = 256;
constexpr int INC = 10248, NG1 = 10240;
constexpr int LC = 256, NCH = SEQ / LC;
constexpr float EPS = 1e-6f;
constexpr int NWAVES = 8, NTHR = 512;

constexpr size_t MiB = 1u << 20;
constexpr size_t WS_CTL = 0, CTL_ZERO_BYTES = 1 * MiB;
constexpr size_t WS_R0 = 1 * MiB;
constexpr size_t WS_DUMP = WS_R0;
constexpr size_t WS_GATEPRE = WS_R0 + 65536;
constexpr size_t WS_GC = WS_GATEPRE + 524288;
constexpr size_t WS_NLOC = WS_GC + 4096;
constexpr size_t WS_DENPART = WS_NLOC + 262144;
constexpr size_t WS_DENINTER = WS_DENPART + 1048576;
constexpr size_t WS_R1 = WS_DENINTER + 262144;
constexpr size_t WS_R2 = WS_R1 + 65536;
constexpr size_t WS_LIST = 4 * MiB;
constexpr size_t WS_LISTW = 6 * MiB;
constexpr size_t WS_SSQ3 = 8 * MiB;
static_assert(WS_R2 + 65536 <= WS_LIST, "small map");
constexpr size_t WS_WB = 16 * MiB, WS_WOUT = 24 * MiB, WS_WPG = 32 * MiB, WS_WPU = 40 * MiB, WS_WSBLK = 41 * MiB;
constexpr size_t WS_WIN = 42 * MiB;
constexpr size_t WS_XB = 82 * MiB;
constexpr size_t WS_PB = 146 * MiB;
constexpr size_t WS_PLEV = 154 * MiB;
constexpr size_t WS_QRAW = 218 * MiB, WS_KRAW = 250 * MiB, WS_VGT = 282 * MiB, WS_VT = 314 * MiB, WS_SO = 346 * MiB, WS_GU = 378 * MiB;
constexpr size_t WS_GATES = 410 * MiB;
constexpr size_t WS_VNT = 538 * MiB;
constexpr size_t WS_HG = 570 * MiB;
constexpr size_t WS_END = 602 * MiB;
constexpr size_t WS_QS = 42 * MiB, WS_KS = 74 * MiB, WS_KST = 106 * MiB;
constexpr size_t WS_P = 218 * MiB, WS_KVT = 250 * MiB;
constexpr size_t WS_CPT = 74 * MiB;
constexpr size_t WS_HM = 106 * MiB;
constexpr size_t WS_MERGED = 250 * MiB;
constexpr size_t WS_MIX = 42 * MiB;
constexpr size_t WS_X1B = 250 * MiB;
constexpr size_t WS_GP = 42 * MiB;
constexpr size_t WS_W13 = 410 * MiB;
constexpr size_t WS_W2 = 346 * MiB;
constexpr size_t WS_H = 106 * MiB;
constexpr size_t WS_Y = 410 * MiB;
constexpr int CW_TMO = 0;
constexpr int CW_CNT = 1024;
constexpr int CW_BAR = 4096;

constexpr int RING_BYTES = 131072;
constexpr int XTR_OFF = RING_BYTES;
constexpr int LDSCTL_OFF = RING_BYTES + 24576, MISC_OFF = LDSCTL_OFF + 320;
constexpr int LDS_BYTES = 163840;

#define RLX_AGENT __ATOMIC_RELAXED, __HIP_MEMORY_SCOPE_AGENT
#define LDS_WAIT() asm volatile("s_waitcnt lgkmcnt(0)" ::: "memory")
#define VM_WAIT() asm volatile("s_waitcnt vmcnt(0)" ::: "memory")
__device__ __forceinline__ unsigned f2bf(float f) { unsigned u = __builtin_bit_cast(unsigned, f); return (u + 0x7fffu + ((u >> 16) & 1u)) >> 16; }

typedef __bf16 bf16v2_t __attribute__((ext_vector_type(2)));
typedef float f32v2_t __attribute__((ext_vector_type(2)));
__device__ __forceinline__ unsigned cvt_pk_bf16(float lo, float hi) { const f32v2_t v = {lo, hi}; return __builtin_bit_cast(unsigned, __builtin_convertvector(v, bf16v2_t)); }
__device__ __forceinline__ unsigned pk2(float lo, float hi) { return cvt_pk_bf16(lo, hi); }
__device__ __forceinline__ float bflo(unsigned w) { return __uint_as_float(w << 16); }
__device__ __forceinline__ float bfhi(unsigned w) { return __uint_as_float(w & 0xffff0000u); }
__device__ __forceinline__ float bf2f(bf16_t b) { return __uint_as_float((unsigned)b << 16); }
__device__ __forceinline__ float fsigmoid(float x) { return __builtin_amdgcn_rcpf(1.0f + __expf(-x)); }
__device__ __forceinline__ float fgelu_tanh(float x) { const float z = 1.5957691216f * (x + 0.044715f * x * x * x); return x * __builtin_amdgcn_rcpf(1.0f + __expf(-z)); }
__device__ __forceinline__ float fsilu(float x) { return x * __builtin_amdgcn_rcpf(1.0f + __expf(-x)); }
__device__ __forceinline__ float wave_sum(float v) {
#pragma unroll
    for (int o = 1; o < 64; o <<= 1) v += __shfl_xor(v, o);
    return v;
}


__device__ __forceinline__ __amdgpu_buffer_rsrc_t ws_rsrc(const unsigned char* ws) { return __builtin_amdgcn_make_buffer_rsrc((void*)ws, 0, 0xffffffffu, 0x00020000); }
__device__ __forceinline__ void wt16(const unsigned char* ws, const void* p, u32x4 v) { __builtin_amdgcn_raw_buffer_store_b128(v, ws_rsrc(ws), (unsigned)((const unsigned char*)p - ws), 0, 16); }
__device__ __forceinline__ void wt16f(const unsigned char* ws, const void* p, f32x4 v) { __builtin_amdgcn_raw_buffer_store_b128(__builtin_bit_cast(u32x4, v), ws_rsrc(ws), (unsigned)((const unsigned char*)p - ws), 0, 16); }
__device__ __forceinline__ void wt8(const unsigned char* ws, const void* p, u32x2 v) { __builtin_amdgcn_raw_buffer_store_b64(v, ws_rsrc(ws), (unsigned)((const unsigned char*)p - ws), 0, 16); }
__device__ __forceinline__ void wt4(const unsigned char* ws, const void* p, unsigned v) { __builtin_amdgcn_raw_buffer_store_b32(v, ws_rsrc(ws), (unsigned)((const unsigned char*)p - ws), 0, 16); }
__device__ __forceinline__ void wt4f(const unsigned char* ws, const void* p, float v) { __builtin_amdgcn_raw_buffer_store_b32(__builtin_bit_cast(unsigned, v), ws_rsrc(ws), (unsigned)((const unsigned char*)p - ws), 0, 16); }

#define XB_TMO      128
#define XB_XCNT(j)  (256  + 64 * (j))
#define XB_XSUB(j)  (1280 + 64 * (j))
#define XB_XGEN(j)  (2304 + 64 * (j))
#define XB_TOP      3328
#define XB_TOPGEN   3392
#define XCD_BAR_WORDS 3456
#define XB_SPIN_CAP (1u << 18)
__device__ __forceinline__ unsigned xb_ld(unsigned* p)              { return __hip_atomic_load(p, __ATOMIC_RELAXED, __HIP_MEMORY_SCOPE_AGENT); }
__device__ __forceinline__ unsigned xb_add(unsigned* p, unsigned v) { return __hip_atomic_fetch_add(p, v, __ATOMIC_RELAXED, __HIP_MEMORY_SCOPE_AGENT); }
__device__ __forceinline__ unsigned xb_xcc_id() { return (unsigned)__builtin_amdgcn_s_getreg((3 << 11) | 20) & 0xFu; }
#define XB_SPIN(cond, bar) do { unsigned _sp = 0; while (cond) { __builtin_amdgcn_s_sleep(1); \
    if ((++_sp & 255u) == 0u) { if (xb_ld(&(bar)[XB_TMO])) break; if (_sp > XB_SPIN_CAP) { atomicAdd(&(bar)[XB_TMO], 1u); break; } } } } while (0)
struct XcdBarrier { unsigned* bar; unsigned x; volatile LAS unsigned* st; };
__device__ __forceinline__ XcdBarrier xcd_barrier_post(unsigned* bar, volatile LAS unsigned* st) {
    XcdBarrier b; b.bar = bar; b.x = xb_xcc_id(); b.st = st;
    if (threadIdx.x == 0) (void)xb_add(&bar[XB_XCNT(b.x)], 1u);
    return b;
}
__device__ __forceinline__ void xcd_barrier_complete(unsigned* bar, unsigned x, unsigned& nloc, unsigned& nx) {
    const unsigned G = gridDim.x * gridDim.y * gridDim.z;
    unsigned sum, cnt, mine, sp = 0u;
    for (;;) {
        sum = 0u; cnt = 0u; mine = 0u;
#pragma unroll
        for (unsigned j = 0; j < 16; ++j) { const unsigned c = xb_ld(&bar[XB_XCNT(j)]); sum += c; cnt += (c > 0u) ? 1u : 0u; mine = (j == x) ? c : mine; }
        if (sum == G) break;
        __builtin_amdgcn_s_sleep(1);
        if ((++sp & 255u) == 0u) { if (xb_ld(&bar[XB_TMO])) break; if (sp > XB_SPIN_CAP) { atomicAdd(&bar[XB_TMO], 1u); break; } }
    }
    nloc = mine > 0u ? mine : 1u; nx = cnt > 0u ? cnt : 1u;
}
__device__ __forceinline__ void xcd_barrier(const XcdBarrier& b) {
    asm volatile("s_waitcnt vmcnt(0)" ::: "memory");
    __syncthreads();
    if (threadIdx.x == 0) {
        unsigned* bar = b.bar;
        __builtin_amdgcn_s_waitcnt(0);
        asm volatile("buffer_inv sc1" ::: "memory");
        unsigned nloc = b.st[0], nx = b.st[1]; const unsigned k = b.st[2]; b.st[2] = k + 1u;
        if (nloc == 0u) { xcd_barrier_complete(bar, b.x, nloc, nx); b.st[0] = nloc; b.st[1] = nx; }
        const unsigned old = xb_add(&bar[XB_XSUB(b.x)], 1u);
        const unsigned gen = old / nloc;
        if (old + 1u == (gen + 1u) * nloc) {
            const unsigned og = xb_add(&bar[XB_TOP], 1u);
            const unsigned tg = og / nx;
            if (og + 1u == (tg + 1u) * nx) xb_add(&bar[XB_TOPGEN], 1u);
        }
        XB_SPIN(xb_ld(&bar[XB_TOPGEN]) == k, bar);
        asm volatile("s_waitcnt vmcnt(0)" ::: "memory");
    }
    __syncthreads();
}

namespace eng {
__device__ __forceinline__ int lane_id2() { int l; asm volatile("v_mbcnt_lo_u32_b32 %0, -1, 0\n\tv_mbcnt_hi_u32_b32 %0, -1, %0" : "=v"(l)); return l; }
constexpr int BM = 256, BK = 64, HALF = 128, HTB = HALF * BK * 2, NXCD = 8, WGM = 8;
__host__ __device__ __forceinline__ int lds_byte(int r, int c) { const int st = (r >> 4) * 2 + (c >> 5), rr = r & 15, cc = c & 31, ob = rr * 64 + cc * 2; return st * 1024 + (ob ^ (((ob >> 9) & 1) << 5)); }
__host__ __device__ __forceinline__ void stage_rc(int b, int& R, int& C) { const int st = b / 1024, sb = b % 1024, swz = sb ^ (((sb >> 9) & 1) << 5); R = (st >> 1) * 16 + swz / 64; C = (st & 1) * 32 + (swz % 64) / 2; }
__host__ __device__ __forceinline__ int perm32(int rho) { const int n = rho >> 4, i = rho & 15; return 8 * (i >> 2) + 4 * n + (i & 3); }

struct Unit { int pm, pn, ex; };
struct USrc { const char* a0; const char* a1; const char* b0; const char* b1; };

struct StaticOrder {
    int nM, nN, nwg, G, c;
    __device__ void init(int Mr, int Nc, int G_, int c_) { nM = Mr / BM; nN = Nc / BM; nwg = nM * nN; G = G_; c = c_; }
    __device__ bool next(int i, Unit& u) const {
        const long L = (long)i * G + c; if (L >= nwg) return false;
        int wgid = (int)L; { const int q = nwg / NXCD, r = nwg % NXCD, xcd = wgid % NXCD, off = wgid / NXCD; wgid = (xcd < r ? xcd * (q + 1) : r * (q + 1) + (xcd - r) * q) + off; }
        const int nig = WGM * nN, gid = wgid / nig, fm = gid * WGM, gsz = (nM - fm) < WGM ? (nM - fm) : WGM;
        u.pm = fm + ((wgid % nig) % gsz); u.pn = (wgid % nig) / gsz; u.ex = 0; return true;
    }
};

template <class Prob>
__device__ __forceinline__ void gemm_phase(LAS unsigned char* lds, const Prob& P, const int wave_id) {
    constexpr int NSEG = Prob::NSEG;
    int lane; asm volatile("v_mbcnt_lo_u32_b32 %0, -1, 0\n\tv_mbcnt_hi_u32_b32 %0, -1, %0" : "=v"(lane));
    const int wid = wave_id, tid = wid * 64 + lane, wr = wid >> 2, wc = wid & 3, fr = lane & 15, fq = lane >> 4;
    int nt = P.nt; asm volatile("" : "+s"(nt));
    const int ksw = P.ksw;
    unsigned Rg0, Rbg0, Cg0;
    { int R, C; stage_rc(tid * 16, R, C); Rg0 = (unsigned)R; Cg0 = (unsigned)C * 2u; asm volatile("" : "+v"(Rg0), "+v"(Cg0));
      if (Prob::PERM) { Rbg0 = (unsigned)((R & ~31) + perm32(R & 31)); asm volatile("" : "+v"(Rbg0)); } else Rbg0 = Rg0; }
    const unsigned ldsw = (unsigned)wid * 1024u;
    const int aoff = lds_byte(wr * 64 + fr, fq * 8), boff = lds_byte(wc * 32 + fr, fq * 8);
    unsigned ag[2][2], agn[2][2];
#define EG_SA(b, h) (((b) * 2 + (h)) * HTB)
#define EG_SB(b, h) ((4 + (b) * 2 + (h)) * HTB)
#define EG_STAGE_B(bufoff, p0, p1, kt, h) do { const bool _sg = (NSEG == 2) && ((kt) >= ksw); const unsigned _ld = _sg ? Prob::ldb1 : Prob::ldb0; \
        const char* _p = _sg ? (p1) + (size_t)((kt) - ksw) * 128 + (size_t)(h) * 128 * Prob::ldb1 : (p0) + (size_t)(kt) * 128 + (size_t)(h) * 128 * Prob::ldb0; \
        const unsigned _vo = Rbg0 * _ld + Cg0; \
        __builtin_amdgcn_global_load_lds((const unsigned*)(_p + _vo), (LAS unsigned*)(lds + (bufoff) + ldsw), 16, 0, 0); \
        __builtin_amdgcn_global_load_lds((const unsigned*)(_p + (size_t)64 * _ld + _vo), (LAS unsigned*)(lds + (bufoff) + ldsw + 8192), 16, 0, 0); } while (0)
#define EG_STAGE_A(bufoff, p0, p1, kt, h) do { if constexpr (Prob::GATHER) { const char* _p = (p0) + (size_t)(kt) * 128; _Pragma("unroll") for (int _i = 0; _i < 2; ++_i) \
        __builtin_amdgcn_global_load_lds((const unsigned*)(_p + (use_n ? agn[h][_i] : ag[h][_i])), (LAS unsigned*)(lds + (bufoff) + ldsw + _i * 8192), 16, 0, 0); } \
    else { const bool _sg = (NSEG == 2) && ((kt) >= ksw); const unsigned _ld = _sg ? Prob::lda1 : Prob::lda0; \
        const char* _p = _sg ? (p1) + (size_t)((kt) - ksw) * 128 + (size_t)(h) * 128 * Prob::lda1 : (p0) + (size_t)(kt) * 128 + (size_t)(h) * 128 * Prob::lda0; \
        const unsigned _vo = Rg0 * _ld + Cg0; \
        __builtin_amdgcn_global_load_lds((const unsigned*)(_p + _vo), (LAS unsigned*)(lds + (bufoff) + ldsw), 16, 0, 0); \
        __builtin_amdgcn_global_load_lds((const unsigned*)(_p + (size_t)64 * _ld + _vo), (LAS unsigned*)(lds + (bufoff) + ldsw + 8192), 16, 0, 0); } } while (0)
#define EG_LDA(dst, b, h) do { _Pragma("unroll") for (int m = 0; m < 4; ++m) _Pragma("unroll") for (int k = 0; k < 2; ++k) dst[m][k] = *(const LAS bf16x8*)(lds + EG_SA(b, h) + aoff + m * 2048 + k * 1024); } while (0)
#define EG_LDB(dst, b, h) do { _Pragma("unroll") for (int n = 0; n < 2; ++n) _Pragma("unroll") for (int k = 0; k < 2; ++k) dst[n][k] = *(const LAS bf16x8*)(lds + EG_SB(b, h) + boff + n * 2048 + k * 1024); } while (0)
#define EG_MMA(ai, bj, At, Bt) do { __builtin_amdgcn_s_setprio(1); _Pragma("unroll") for (int m = 0; m < 4; ++m) _Pragma("unroll") for (int n = 0; n < 2; ++n) _Pragma("unroll") for (int k = 0; k < 2; ++k) \
        acc[ai][bj][m][n] = __builtin_amdgcn_mfma_f32_16x16x32_bf16(Bt[n][k], At[m][k], acc[ai][bj][m][n], 0, 0, 0); __builtin_amdgcn_s_setprio(0); } while (0)
#define EG_WAIT_V(n) asm volatile("s_waitcnt vmcnt(" #n ")" ::: "memory")
#define EG_WAIT_V8R(relax) do { if (relax) asm volatile("s_waitcnt vmcnt(%0)" :: "n"(8 + Prob::EPI_VM) : "memory"); else EG_WAIT_V(8); } while (0)
#define EG_WAIT_L(n) asm volatile("s_waitcnt lgkmcnt(" #n ")" ::: "memory")
#define EG_BAR __builtin_amdgcn_s_barrier()
#define EG_SCHED __builtin_amdgcn_sched_barrier(0)
    Unit cur, nxt; int ui = 0;
    if (!P.next(0, cur)) return;
    USrc sc, sn; P.src(cur, sc);
    if constexpr (Prob::GATHER) {
#pragma unroll
        for (int h = 0; h < 2; ++h)
#pragma unroll
            for (int i = 0; i < 2; ++i) { ag[h][i] = P.arow(cur, h * 128 + i * 64 + (int)Rg0) + Cg0; asm volatile("" : "+v"(ag[h][i])); }
    }
    u32x2 keep[2][4][2];
#pragma unroll
    for (int a = 0; a < 2; ++a)
#pragma unroll
        for (int m = 0; m < 4; ++m) { keep[a][m][0] = (u32x2){0u, 0u}; keep[a][m][1] = (u32x2){0u, 0u}; }
    f32x4 acc[2][2][4][2];
#pragma unroll
    for (int a = 0; a < 2; ++a)
#pragma unroll
        for (int b = 0; b < 2; ++b)
#pragma unroll
            for (int m = 0; m < 4; ++m)
#pragma unroll
                for (int n = 0; n < 2; ++n) acc[a][b][m][n] = (f32x4){0.f, 0.f, 0.f, 0.f};
    bf16x8 At[4][2], B0[2][2], B1[2][2];
    bool use_n = false;
    EG_STAGE_B(EG_SB(0, 0), sc.b0, sc.b1, 0, 0); EG_STAGE_B(EG_SB(0, 1), sc.b0, sc.b1, 0, 1); EG_STAGE_A(EG_SA(0, 0), sc.a0, sc.a1, 0, 0); EG_STAGE_A(EG_SA(0, 1), sc.a0, sc.a1, 0, 1);
    if (wr == 1) EG_BAR;
    EG_WAIT_V(2); EG_BAR;
    EG_STAGE_B(EG_SB(1, 0), sc.b0, sc.b1, 1, 0); EG_STAGE_A(EG_SA(1, 0), sc.a0, sc.a1, 1, 0); EG_STAGE_B(EG_SB(1, 1), sc.b0, sc.b1, 1, 1);
    EG_WAIT_V(6); EG_BAR;
    for (;;) {
        const bool has_next = P.next(ui + 1, nxt);
        if (has_next) P.src(nxt, sn); else sn = sc;
        for (int t = 0; t < nt; t += 2) {
            const bool last = (t == nt - 2);
            const char* qa0 = last ? sn.a0 : sc.a0; const char* qa1 = last ? sn.a1 : sc.a1; const char* qb0 = last ? sn.b0 : sc.b0; const char* qb1 = last ? sn.b1 : sc.b1;
            const int k2 = last ? 0 : t + 2, k3 = k2 + 1;
            if constexpr (Prob::HAS_MID) { if (t == P.mid_kt) { const int l2 = lane_id2(); P.mid(acc, keep, cur, wr, wc, l2 & 15, l2 >> 4); } }
            const bool relax = (Prob::EPI_VM > 0) && (t == 0) && (ui > 0);
            EG_LDB(B0, 0, 0); EG_LDB(B1, 0, 1); EG_SCHED; EG_LDA(At, 0, 0); if (!relax) EG_STAGE_A(EG_SA(1, 1), sc.a0, sc.a1, t + 1, 1);
            EG_WAIT_V8R(relax); EG_WAIT_L(0); EG_BAR; EG_MMA(0, 0, At, B0); EG_MMA(0, 1, At, B1); EG_BAR; EG_SCHED;
            if constexpr (Prob::GATHER) {
                if (last && has_next) {
#pragma unroll
                    for (int h = 0; h < 2; ++h)
#pragma unroll
                        for (int i = 0; i < 2; ++i) { agn[h][i] = P.arow(nxt, h * 128 + i * 64 + (int)Rg0) + Cg0; asm volatile("" : "+v"(agn[h][i])); }
                    use_n = true; }
            }
            EG_LDA(At, 0, 1); EG_STAGE_B(EG_SB(0, 0), qb0, qb1, k2, 0); EG_STAGE_B(EG_SB(0, 1), qb0, qb1, k2, 1); EG_STAGE_A(EG_SA(0, 0), qa0, qa1, k2, 0);
            EG_WAIT_V8R(relax); EG_WAIT_L(0); EG_BAR; EG_MMA(1, 0, At, B0); EG_MMA(1, 1, At, B1); EG_BAR; EG_SCHED;
            EG_LDB(B0, 1, 0); EG_LDB(B1, 1, 1); EG_SCHED; EG_LDA(At, 1, 0); EG_STAGE_A(EG_SA(0, 1), qa0, qa1, k2, 1);
            EG_WAIT_V8R(relax); EG_WAIT_L(0); EG_BAR; EG_MMA(0, 0, At, B0); EG_MMA(0, 1, At, B1); EG_BAR; EG_SCHED;
            EG_LDA(At, 1, 1); EG_STAGE_B(EG_SB(1, 0), qb0, qb1, k3, 0); EG_STAGE_B(EG_SB(1, 1), qb0, qb1, k3, 1); EG_STAGE_A(EG_SA(1, 0), qa0, qa1, k3, 0);
            EG_WAIT_V(8); EG_WAIT_L(0); EG_BAR; EG_MMA(1, 0, At, B0); EG_MMA(1, 1, At, B1); EG_BAR; EG_SCHED;
        }
        if constexpr (Prob::EPI_VM > 0) { if (has_next) EG_STAGE_A(EG_SA(1, 1), sn.a0, sn.a1, 1, 1); }
        if constexpr (Prob::ALIGN) { if (wr == 0) EG_BAR; }
        if constexpr (!Prob::AFTER_DRAIN) { const int l2 = lane_id2(); if constexpr (Prob::HAS_MID) P.epi_keep(acc, keep, cur, wr, wc, l2 & 15, l2 >> 4); else P.epi(acc, cur, wr, wc, l2 & 15, l2 >> 4); }
        if (!has_next) break;
#pragma unroll
        for (int a = 0; a < 2; ++a)
#pragma unroll
            for (int b = 0; b < 2; ++b)
#pragma unroll
                for (int m = 0; m < 4; ++m)
#pragma unroll
                    for (int n = 0; n < 2; ++n) acc[a][b][m][n] = (f32x4){0.f, 0.f, 0.f, 0.f};
        cur = nxt; sc = sn; ++ui;
        if constexpr (Prob::GATHER) { ag[0][0] = agn[0][0]; ag[0][1] = agn[0][1]; ag[1][0] = agn[1][0]; ag[1][1] = agn[1][1]; use_n = false; }
        if constexpr (Prob::ALIGN) { if (wr == 1) EG_BAR; }
    }
    EG_WAIT_V(0);
    if constexpr (!Prob::ALIGN) { if (wr == 0) EG_BAR; }
    EG_BAR;
    if constexpr (Prob::AFTER_DRAIN) { const int l2 = lane_id2(); P.fused(acc, cur, wr, wc, l2 & 15, l2 >> 4, lds, wid, l2); }
#undef EG_SA
#undef EG_SB
#undef EG_STAGE_A
#undef EG_STAGE_B
#undef EG_LDA
#undef EG_LDB
#undef EG_MMA
#undef EG_WAIT_V
#undef EG_WAIT_V8R
#undef EG_WAIT_L
#undef EG_BAR
#undef EG_SCHED
}
}
using eng::Unit; using eng::USrc;
typedef f32x4 Acc[2][2][4][2];

struct Frame {
    LAS unsigned char* lds;
    volatile LAS unsigned* MISC;
    gu32* ctl;
    int wave, vcu, G;
    float* out; unsigned char* ws;
};
#define WSP(T, off) ((T*)(F.ws + (off)))
__device__ __forceinline__ int lane_id() { int l; asm volatile("v_mbcnt_lo_u32_b32 %0, -1, 0\n\tv_mbcnt_hi_u32_b32 %0, -1, %0" : "=v"(l)); return l; }
#define E0(j) (512 * ((j) >> 1) + 8 * lane + 4 * ((j) & 1))
#define DECL_TID const int lane = lane_id(), tid = F.wave * 64 + lane; (void)tid; (void)lane;
struct Args { const float* in[27]; float* out; unsigned char* ws; int ph_lo, ph_hi; };
#define INP(i) (args.in[i])

__device__ __forceinline__ u32x4 pack8(const f32x4 v0, const f32x4 v1) { u32x4 w; w.x = cvt_pk_bf16(v0[0], v0[1]); w.y = cvt_pk_bf16(v0[2], v0[3]); w.z = cvt_pk_bf16(v1[0], v1[1]); w.w = cvt_pk_bf16(v1[2], v1[3]); return w; }
template <int ACT> __device__ __forceinline__ f32x4 act4(f32x4 v) {
    if (ACT == 1) { v[0] = fsigmoid(v[0]); v[1] = fsigmoid(v[1]); v[2] = fsigmoid(v[2]); v[3] = fsigmoid(v[3]); }
    if (ACT == 2) { v[0] = fgelu_tanh(v[0]); v[1] = fgelu_tanh(v[1]); v[2] = fgelu_tanh(v[2]); v[3] = fgelu_tanh(v[3]); }
    return v;
}

constexpr int TSCR_BYTES = 64 * 65 * 4;
__device__ __forceinline__ void transpose_item(const unsigned char* ws_base_, const float* slp, size_t srcld, const float* ksc, int k0, bf16_t* dst, size_t dstld, LAS float* scr, int lane) {
    const int kr = lane >> 4, ns = (lane & 15) * 4;
    f32x4 v[16];
#pragma unroll
    for (int i = 0; i < 16; ++i) v[i] = __builtin_nontemporal_load((const GAS f32x4*)(slp + (size_t)(k0 + 4 * i + kr) * srcld));
#pragma unroll
    for (int i = 0; i < 16; ++i) { const int kk = 4 * i + kr; f32x4 w = v[i]; if (ksc) w = w * ksc[k0 + kk];
        LAS float* p = scr + kk * 65 + ns; p[0] = w[0]; p[1] = w[1]; p[2] = w[2]; p[3] = w[3]; }
    LDS_WAIT(); asm volatile("" ::: "memory");
    const int c = lane & 7, nl = lane >> 3;
#pragma unroll
    for (int p = 0; p < 8; ++p) { const int n = 8 * p + nl; const LAS float* q = scr + (8 * c) * 65 + n;
        u32x4 o; o.x = pk2(q[0 * 65], q[1 * 65]); o.y = pk2(q[2 * 65], q[3 * 65]); o.z = pk2(q[4 * 65], q[5 * 65]); o.w = pk2(q[6 * 65], q[7 * 65]);
        wt16(ws_base_, dst + (size_t)n * dstld + 8 * c, o); }
    LDS_WAIT(); asm volatile("" ::: "memory");
}

__device__ __forceinline__ void p0_prologue(Frame& F, const Args& args) {
    const unsigned char* ws_base_ = F.ws;
    LAS float* scr = (LAS float*)(F.lds + F.wave * TSCR_BYTES);
    DECL_TID; const int gw = F.vcu * NWAVES + F.wave, NGW = F.G * NWAVES;
    const float* w_in = INP(3); const float* g_mix = INP(2);
    constexpr int I_IN = 32 * 160, I_BM = 16 * 32, I_BG = 16 * 32, I_OUT = 32 * 32, I_PG = 32 * 32, I_PU = 4 * 32;
    constexpr int NITEMS = I_IN + I_BM + I_BG + I_OUT + I_PG + I_PU;
    const int ns4 = (lane & 15) * 4;
    for (int it = gw; it < NITEMS; it += NGW) {
        int r = it;
        if (r < I_IN) { const int kb = r / 160, nb = r % 160, d0 = nb * 64, sc0 = d0 < 4096 ? d0 : d0 + 8;
            transpose_item(F.ws, w_in + sc0 + ns4, INC, g_mix, kb * 64, WSP(bf16_t, WS_WIN) + (size_t)d0 * D + kb * 64, D, scr, lane); continue; } r -= I_IN;
        if (r < I_BM) { const int kb = r / 32, nb = r % 32;
            transpose_item(F.ws, INP(12) + nb * 64 + ns4, D, nullptr, kb * 64, WSP(bf16_t, WS_WB) + (size_t)(nb * 64) * D + kb * 64, D, scr, lane); continue; } r -= I_BM;
        if (r < I_BG) { const int kb = r / 32, nb = r % 32;
            transpose_item(F.ws, INP(13) + nb * 64 + ns4, D, nullptr, kb * 64, WSP(bf16_t, WS_WB) + (size_t)(nb * 64) * D + MW + kb * 64, D, scr, lane); continue; } r -= I_BG;
        if (r < I_OUT) { const int kb = r / 32, nb = r % 32;
            transpose_item(F.ws, INP(14) + nb * 64 + ns4, D, nullptr, kb * 64, WSP(bf16_t, WS_WOUT) + (size_t)(nb * 64) * D + kb * 64, D, scr, lane); continue; } r -= I_OUT;
        if (r < I_PG) { const int kb = r / 32, nb = r % 32;
            transpose_item(F.ws, INP(25) + nb * 64 + ns4, D, INP(23), kb * 64, WSP(bf16_t, WS_WPG) + (size_t)(nb * 64) * D + kb * 64, D, scr, lane); continue; } r -= I_PG;
        { const int kb = r / 32, nb = r % 32;
            transpose_item(F.ws, INP(24) + nb * 64 + ns4, D, nullptr, kb * 64, WSP(bf16_t, WS_WPU) + (size_t)(nb * 64) * PLE + kb * 64, PLE, scr, lane); }
    }
    const int gt = F.vcu * NTHR + tid, NGT = F.G * NTHR;
    { const float* w_s = INP(10); bf16_t* wsb = WSP(bf16_t, WS_WSBLK);
      for (int i2 = gt; i2 < 4 * 256 * 256 / 2; i2 += NGT) { const int idx = i2 * 2, gp = idx >> 16, r = (idx >> 8) & 255, c = idx & 255, gi = r >> 7, t = r & 127, gj = c >> 7, s = c & 127;
          const float v0 = (gi == gj && s <= t) ? w_s[(size_t)(2 * gp + gi) * 16384 + t * 128 + s] : 0.f, v1 = (gi == gj && s + 1 <= t) ? w_s[(size_t)(2 * gp + gi) * 16384 + t * 128 + s + 1] : 0.f;
          wt4(ws_base_, wsb + idx, pk2(v0, v1)); } }
    { const float* p = INP(1); bf16_t* pb = WSP(bf16_t, WS_PB);
      for (int idx = gt; idx < M * PLE / 8; idx += NGT) { const f32x4 a = *(const GAS f32x4*)(p + (size_t)idx * 8), b = *(const GAS f32x4*)(p + (size_t)idx * 8 + 4);
          u32x4 o; o.x = pk2(a[0], a[1]); o.y = pk2(a[2], a[3]); o.z = pk2(b[0], b[1]); o.w = pk2(b[2], b[3]); wt16(ws_base_, pb + (size_t)idx * 8, o); } }
    __syncthreads();
    LAS float* g8 = (LAS float*)F.lds;
    for (int idx = tid; idx < 8 * D; idx += NTHR) { const int k = idx >> 3, j = idx & 7; g8[j * D + k] = w_in[(size_t)k * INC + 4096 + j] * g_mix[k]; }
    __syncthreads();
    { const float* x = INP(0); const float* b_gate = INP(6); bf16_t* xb = WSP(bf16_t, WS_XB); float* gp = WSP(float, WS_GATEPRE);
      for (int m = gw; m < M; m += NGW) {
          const float* xrow = x + (size_t)m * D;
          f32x4 v[8]; float ss = 0.f;
#pragma unroll
          for (int j = 0; j < 8; ++j) { v[j] = *(const GAS f32x4*)(xrow + E0(j)); ss += (v[j][0] * v[j][0] + v[j][1] * v[j][1]) + (v[j][2] * v[j][2] + v[j][3] * v[j][3]); }
          float mine = 0.f;
#pragma unroll 1
          for (int g = 0; g < 8; ++g) { float a = 0.f;
#pragma unroll
              for (int j = 0; j < 8; ++j) { const f32x4 w = *(const LAS f32x4*)(g8 + g * D + E0(j)); a += (v[j][0] * w[0] + v[j][1] * w[1]) + (v[j][2] * w[2] + v[j][3] * w[3]); }
              a = wave_sum(a); mine = (lane == g) ? a : mine; }
          ss = wave_sum(ss);
          const float r = 1.0f / sqrtf(ss * (1.0f / D) + EPS);
#pragma unroll
          for (int p = 0; p < 4; ++p) wt16(ws_base_, xb + (size_t)m * D + 512 * p + 8 * lane, pack8(v[2 * p] * r, v[2 * p + 1] * r));
          if (lane < 8) wt4f(ws_base_, gp + (size_t)m * 8 + lane, r * mine + b_gate[lane]);
      } }
    __syncthreads();
}

struct ProbG1 {
    static constexpr int EPI_VM = 8;  static constexpr bool PERM = true, AFTER_DRAIN = false, ALIGN = true, HAS_MID = false, GATHER = false; static constexpr int NSEG = 1; static constexpr unsigned lda0 = 4096u, lda1 = 4096u, ldb0 = 4096u, ldb1 = 4096u;
    int nt, ksw, mid_kt; eng::StaticOrder S; unsigned char* ws;
    __device__ __forceinline__ bool next(int i, Unit& u) const { return S.next(i, u); }
    __device__ __forceinline__ void src(const Unit& u, USrc& s) const {
        const int cb = u.pn >> 2; const bool sw = (cb == 2 || cb == 5);
        const char* xa = (const char*)(ws + WS_XB) + (size_t)u.pm * 256 * 4096; const char* wa = (const char*)(ws + WS_WIN) + (size_t)u.pn * 256 * 4096;
        s.a0 = sw ? wa : xa; s.b0 = sw ? xa : wa; s.a1 = s.a0; s.b1 = s.b0;
    }
    template <int ACT> __device__ __forceinline__ void epi_nat(const Acc& acc, const Unit& u, int wr, int wc, int fr, int fq, bf16_t* dst, int ldd, int colt) const {
        const unsigned char* ws_base_ = ws;
        const int row0 = u.pm * 256 + wr * 64 + fr, col0 = colt + wc * 32 + 8 * fq;
#pragma unroll
        for (int ai = 0; ai < 2; ++ai)
#pragma unroll
            for (int m = 0; m < 4; ++m) { const int row = row0 + ai * 128 + m * 16; bf16_t* rowp = dst + (size_t)row * ldd + col0;
#pragma unroll
                for (int bj = 0; bj < 2; ++bj) { const f32x4 v0 = act4<ACT>(acc[ai][bj][m][0]), v1 = act4<ACT>(acc[ai][bj][m][1]);
                    wt16(ws_base_, rowp + bj * 128, pack8(v0, v1)); } }
    }
    template <int ACT, bool CHUNKED> __device__ __forceinline__ void epi_swp(const Acc& acc, const Unit& u, int wr, int wc, int fr, int fq, bf16_t* dst) const {
        const unsigned char* ws_base_ = ws;
        const int ch0 = (u.pn & 3) * 256 + wr * 64 + fr, tk0 = u.pm * 256 + wc * 32 + 8 * fq;
#pragma unroll
        for (int ai = 0; ai < 2; ++ai)
#pragma unroll
            for (int m = 0; m < 4; ++m) { bf16_t* rowp = CHUNKED ? dst + ((size_t)(((u.pm >> 4) * MH + (u.pn & 3)) * NCH + (u.pm & 15)) * 256 + (wr * 64 + fr + ai * 128 + m * 16)) * 256 + wc * 32 + 8 * fq
                                                                       : dst + (size_t)(ch0 + ai * 128 + m * 16) * M + tk0;
#pragma unroll
                for (int bj = 0; bj < 2; ++bj) { const f32x4 v0 = act4<ACT>(acc[ai][bj][m][0]), v1 = act4<ACT>(acc[ai][bj][m][1]);
                    wt16(ws_base_, rowp + bj * 128, pack8(v0, v1)); } }
    }
    static __device__ __forceinline__ unsigned pack4u8(const f32x4 v, const unsigned lo) {
        const unsigned q0 = max((unsigned)fmaf(v[0], 255.f, 0.5f), lo), q1 = max((unsigned)fmaf(v[1], 255.f, 0.5f), lo), q2 = max((unsigned)fmaf(v[2], 255.f, 0.5f), lo), q3 = max((unsigned)fmaf(v[3], 255.f, 0.5f), lo);
        return q0 | (q1 << 8) | (q2 << 16) | (q3 << 24); }
    __device__ __forceinline__ void epi_gate8(const Acc& acc, const Unit& u, int wr, int wc, int fr, int fq) const {
        const unsigned char* ws_base_ = ws; unsigned char* gt = ws + WS_GATES + (size_t)(u.pm * 16 + (u.pn - 24)) * 65536;
        const unsigned lo = u.pn >= 32 ? 1u : 0u; const bool odd = (fq & 1) != 0;
        const int lofs = (odd ? 512 : 0) + fr * 32 + (fq & ~1) * 8;
#pragma unroll
        for (int ai = 0; ai < 2; ++ai)
#pragma unroll
            for (int m = 0; m < 4; ++m) { const int q = ((ai * 2 + wr) * 4 + m) * 4 + wc;
                u32x2 w0, w1;
                w0.x = pack4u8(act4<1>(acc[ai][0][m][0]), lo); w0.y = pack4u8(act4<1>(acc[ai][0][m][1]), lo);
                w1.x = pack4u8(act4<1>(acc[ai][1][m][0]), lo); w1.y = pack4u8(act4<1>(acc[ai][1][m][1]), lo);
                const unsigned sx = odd ? w0.x : w1.x, sy = odd ? w0.y : w1.y;
                const unsigned px = (unsigned)__shfl_xor((int)sx, 16), py = (unsigned)__shfl_xor((int)sy, 16);
                u32x4 o; if (!odd) { o.x = w0.x; o.y = w0.y; o.z = px; o.w = py; } else { o.x = px; o.y = py; o.z = w1.x; o.w = w1.y; }
                wt16(ws_base_, gt + q * 1024 + lofs, o); }
    }
    __device__ __forceinline__ void epi(const Acc& acc, const Unit& u, int wr, int wc, int fr, int fq) const { asm volatile("" : "+v"(fr), "+v"(fq)); const unsigned char* ws_base_ = ws; (void)ws_base_;
        const int cb = u.pn >> 2, colt = (u.pn & 3) * 256;
        if (cb == 0) epi_nat<0>(acc, u, wr, wc, fr, fq, (bf16_t*)(ws + WS_QRAW), MW, colt);
        else if (cb == 1) epi_nat<0>(acc, u, wr, wc, fr, fq, (bf16_t*)(ws + WS_KRAW), MW, colt);
        else if (cb == 2) epi_swp<0, true>(acc, u, wr, wc, fr, fq, (bf16_t*)(ws + WS_VT));
        else if (cb == 3) epi_nat<1>(acc, u, wr, wc, fr, fq, (bf16_t*)(ws + WS_SO), MW, colt);
        else if (cb == 4) epi_nat<2>(acc, u, wr, wc, fr, fq, (bf16_t*)(ws + WS_GU), GW, colt);
        else if (cb == 5) epi_swp<2, false>(acc, u, wr, wc, fr, fq, (bf16_t*)(ws + WS_VGT));
        else epi_gate8(acc, u, wr, wc, fr, fq);
    }
};
struct ProbPU {
    static constexpr int EPI_VM = 16; static constexpr bool PERM = true, AFTER_DRAIN = false, ALIGN = true, HAS_MID = false, GATHER = false; static constexpr int NSEG = 1; static constexpr unsigned lda0 = 512u, lda1 = 512u, ldb0 = 512u, ldb1 = 512u;
    int nt, ksw, mid_kt; eng::StaticOrder S; unsigned char* ws;
    __device__ __forceinline__ bool next(int i, Unit& u) const { return S.next(i, u); }
    __device__ __forceinline__ void src(const Unit& u, USrc& s) const {
        s.a0 = s.a1 = (const char*)(ws + WS_PB) + (size_t)u.pm * 256 * 512; s.b0 = s.b1 = (const char*)(ws + WS_WPU) + (size_t)u.pn * 256 * 512;
    }
    __device__ __forceinline__ void epi(const Acc& acc, const Unit& u, int wr, int wc, int fr, int fq) const { asm volatile("" : "+v"(fr), "+v"(fq)); const unsigned char* ws_base_ = ws; (void)ws_base_;
        bf16_t* dst = (bf16_t*)(ws + WS_PLEV) + (size_t)(u.pm * 8 + u.pn) * 65536 + fr * 32 + fq * 8;
#pragma unroll
        for (int ai = 0; ai < 2; ++ai)
#pragma unroll
            for (int m = 0; m < 4; ++m)
#pragma unroll
                for (int bj = 0; bj < 2; ++bj) wt16(ws_base_, dst + ((((ai * 2 + wr) * 4 + m) * 4 + wc) * 2 + bj) * 512, pack8(acc[ai][bj][m][0], acc[ai][bj][m][1]));
    }
};

constexpr int CW_TICK = 3200;
__device__ __forceinline__ void p2_elementwise(Frame& F, const Args& args, const int part) {
    const unsigned char* ws_base_ = F.ws;
    DECL_TID;
    LAS float* sb = (LAS float*)F.lds;
    LAS float* seq = sb + 256;
    LAS float* sek = sb + 512;
    LAS float* nl = sb + 1024;
    const float* gpre = WSP(float, WS_GATEPRE);
    const float* conv_w = INP(4); const float* conv_b = INP(5);
    if (part == 0) for (int un = (int)blockIdx.x; un < BATCH * NCH * MH; un += F.G) {
        const int bh = un >> 4, c = un & 15, b = bh >> 2, h = bh & 3, t0 = b * SEQ + c * LC;
        float lf = 0.f, ip = 0.f;
        if (tid < 256) { const float fp = gpre[(size_t)(t0 + tid) * 8 + 4 + h]; ip = gpre[(size_t)(t0 + tid) * 8 + h];
            lf = fminf(fp, 0.f) - log1pf(__expf(-fabsf(fp))); sb[tid] = lf; }
        __syncthreads();
        for (int o = 1; o < 256; o <<= 1) { float a = 0.f; if (tid < 256) { a = sb[tid]; if (tid >= o) a += sb[tid - o]; } __syncthreads(); if (tid < 256) sb[tid] = a; __syncthreads(); }
        if (tid < 256) { const float bl = sb[tid]; seq[tid] = __expf(bl); sek[tid] = __expf(ip - bl); if (tid == 255) wt4f(ws_base_, WSP(float, WS_GC) + bh * NCH + c, bl); }
        __syncthreads();
        for (int pass = 0; pass < 4; ++pass) {
            const bool isk = pass >= 2; const int blk = (pass & 1) * 512 + tid, ds = blk & 31, rg = blk >> 5, l0 = rg * 8, d0 = ds * 8;
            const int ch = (isk ? MW : 0) + h * DH + d0;
            const bf16_t* src = WSP(bf16_t, isk ? WS_KRAW : WS_QRAW) + (size_t)h * DH + d0;
            float w[4][8], bias[8];
#pragma unroll
            for (int j = 0; j < 4; ++j) { const f32x4 a = *(const GAS f32x4*)(conv_w + (size_t)j * 2048 + ch), bq = *(const GAS f32x4*)(conv_w + (size_t)j * 2048 + ch + 4);
                w[j][0] = a[0]; w[j][1] = a[1]; w[j][2] = a[2]; w[j][3] = a[3]; w[j][4] = bq[0]; w[j][5] = bq[1]; w[j][6] = bq[2]; w[j][7] = bq[3]; }
            { const f32x4 a = *(const GAS f32x4*)(conv_b + ch), bq = *(const GAS f32x4*)(conv_b + ch + 4); bias[0] = a[0]; bias[1] = a[1]; bias[2] = a[2]; bias[3] = a[3]; bias[4] = bq[0]; bias[5] = bq[1]; bias[6] = bq[2]; bias[7] = bq[3]; }
            u32x4 raw[11];
#pragma unroll
            for (int i = 0; i < 11; ++i) { const int l = l0 - 3 + i; const bool ok = (c > 0) || (l >= 0);
                raw[i] = ok ? *(const GAS u32x4*)(src + (size_t)(t0 + l) * MW) : (u32x4){0u, 0u, 0u, 0u}; }
            float val[8][8];
#pragma unroll
            for (int r = 0; r < 8; ++r) {
                float y[8];
#pragma unroll
                for (int d = 0; d < 8; ++d) y[d] = bias[d];
#pragma unroll
                for (int j = 0; j < 4; ++j) { const u32x4 x = raw[r + j];
                    y[0] += w[j][0] * bflo(x.x); y[1] += w[j][1] * bfhi(x.x); y[2] += w[j][2] * bflo(x.y); y[3] += w[j][3] * bfhi(x.y);
                    y[4] += w[j][4] * bflo(x.z); y[5] += w[j][5] * bfhi(x.z); y[6] += w[j][6] * bflo(x.w); y[7] += w[j][7] * bfhi(x.w); }
                const float sc = isk ? sek[l0 + r] * 0.0625f : seq[l0 + r];
#pragma unroll
                for (int d = 0; d < 8; ++d) val[r][d] = fsilu(y[d]) * sc;
            }
            bf16_t* dn = WSP(bf16_t, isk ? WS_KS : WS_QS) + (size_t)(bh * NCH + c) * 65536 + d0;
#pragma unroll
            for (int r = 0; r < 8; ++r) { u32x4 o; o.x = cvt_pk_bf16(val[r][0], val[r][1]); o.y = cvt_pk_bf16(val[r][2], val[r][3]); o.z = cvt_pk_bf16(val[r][4], val[r][5]); o.w = cvt_pk_bf16(val[r][6], val[r][7]);
                wt16(ws_base_, dn + (size_t)(l0 + r) * 256, o); }
            if (isk) {
                bf16_t* dt = WSP(bf16_t, WS_KST) + (size_t)(bh * NCH + c) * 65536 + (size_t)d0 * 256 + l0;
#pragma unroll
                for (int d = 0; d < 8; ++d) { u32x4 o; o.x = cvt_pk_bf16(val[0][d], val[1][d]); o.y = cvt_pk_bf16(val[2][d], val[3][d]); o.z = cvt_pk_bf16(val[4][d], val[5][d]); o.w = cvt_pk_bf16(val[6][d], val[7][d]);
                    wt16(ws_base_, dt + (size_t)d * 256, o); }
#pragma unroll
                for (int d = 0; d < 8; ++d) { float s = 0.f;
#pragma unroll
                    for (int r = 0; r < 8; ++r) s += val[r][d];
                    nl[rg * 256 + d0 + d] = s; }
            }
        }
        __syncthreads();
        if (tid < 256) { float s = 0.f;
#pragma unroll 8
            for (int rg = 0; rg < 32; ++rg) s += nl[rg * 256 + tid];
            wt4f(ws_base_, WSP(float, WS_NLOC) + (size_t)(bh * NCH + c) * 256 + tid, s); }
        __syncthreads();
    }
    LAS float* rs = (LAS float*)F.lds;
    LAS float* rq = rs + 4096;
    LAS float* smu = rq + 4096;
    LAS float* srs = smu + 64;
    const float* ln_g = INP(8); const float* ln_b = INP(9);
    if (part == 1) for (;;) {
        if (tid == 0) F.MISC[16] = __hip_atomic_fetch_add((unsigned*)(F.ctl + CW_TICK), 1u, RLX_AGENT);
        __syncthreads();
        const int un = (int)F.MISC[16];
        if (un >= M / 64) break;
        const int ts = tid & 7, cg = tid >> 3, tk = un * 64 + ts * 8;
        const bf16_t* src = WSP(bf16_t, WS_VGT) + (size_t)(cg * 16) * M + tk;
        u32x4 raw[16]; float s[8], q[8];
#pragma unroll
        for (int d = 0; d < 8; ++d) { s[d] = 0.f; q[d] = 0.f; }
#pragma unroll
        for (int i = 0; i < 16; ++i) { raw[i] = *(const GAS u32x4*)(src + (size_t)i * M);
            const float v0 = bflo(raw[i].x), v1 = bfhi(raw[i].x), v2 = bflo(raw[i].y), v3 = bfhi(raw[i].y), v4 = bflo(raw[i].z), v5 = bfhi(raw[i].z), v6 = bflo(raw[i].w), v7 = bfhi(raw[i].w);
            s[0] += v0; s[1] += v1; s[2] += v2; s[3] += v3; s[4] += v4; s[5] += v5; s[6] += v6; s[7] += v7;
            q[0] += v0 * v0; q[1] += v1 * v1; q[2] += v2 * v2; q[3] += v3 * v3; q[4] += v4 * v4; q[5] += v5 * v5; q[6] += v6 * v6; q[7] += v7 * v7; }
#pragma unroll
        for (int d = 0; d < 8; ++d) { rs[cg * 64 + ts * 8 + d] = s[d]; rq[cg * 64 + ts * 8 + d] = q[d]; }
        __syncthreads();
        if (tid < 64) { float a = 0.f, bq = 0.f;
#pragma unroll 8
            for (int g = 0; g < 64; ++g) { a += rs[g * 64 + tid]; bq += rq[g * 64 + tid]; }
            const float mu = a * (1.0f / GW), var = fmaxf(bq * (1.0f / GW) - mu * mu, 0.f); smu[tid] = mu; srs[tid] = 1.0f / sqrtf(var + EPS); }
        __syncthreads();
        float mu[8], rr[8];
#pragma unroll
        for (int d = 0; d < 8; ++d) { mu[d] = smu[ts * 8 + d]; rr[d] = srs[ts * 8 + d]; }
        const int chunk = tk >> 7, s0 = tk & 127;
#pragma unroll
        for (int i = 0; i < 16; ++i) { const int ch = cg * 16 + i; const float g = ln_g[ch], bb = ln_b[ch];
            const float v0 = (bflo(raw[i].x) - mu[0]) * rr[0] * g + bb, v1 = (bfhi(raw[i].x) - mu[1]) * rr[1] * g + bb, v2 = (bflo(raw[i].y) - mu[2]) * rr[2] * g + bb, v3 = (bfhi(raw[i].y) - mu[3]) * rr[3] * g + bb;
            const float v4 = (bflo(raw[i].z) - mu[4]) * rr[4] * g + bb, v5 = (bfhi(raw[i].z) - mu[5]) * rr[5] * g + bb, v6 = (bflo(raw[i].w) - mu[6]) * rr[6] * g + bb, v7 = (bfhi(raw[i].w) - mu[7]) * rr[7] * g + bb;
            u32x4 o; o.x = cvt_pk_bf16(v0, v1); o.y = cvt_pk_bf16(v2, v3); o.z = cvt_pk_bf16(v4, v5); o.w = cvt_pk_bf16(v6, v7);
            const int gp = ch >> 8, gj = (ch >> 7) & 1, e = ch & 127;
            wt16(ws_base_, WSP(bf16_t, WS_VNT) + ((((size_t)gp * 128 + chunk) * 128 + e) * 2 + gj) * 128 + s0, o); }
        __syncthreads();
    }
}

struct ProbP3 {
    static constexpr int EPI_VM = 16; static constexpr bool PERM = true, AFTER_DRAIN = false, ALIGN = true, HAS_MID = false, GATHER = false; static constexpr int NSEG = 1; static constexpr unsigned lda0 = 512u, lda1 = 512u, ldb0 = 512u, ldb1 = 512u;
    int nt, ksw, mid_kt; int G, c0, mode; unsigned char* ws; const float* b_s;
    __device__ __forceinline__ bool next(int i, Unit& u) const { u.pn = 0;
        if (mode == 0) { const int sub = (i >> 1) * G + c0; if (sub >= 256) return false; u.ex = i & 1; u.pm = sub; return true; }
        const int sub = i * G + c0; if (sub >= 256) return false; u.ex = 2; u.pm = sub; return true; }
    __device__ __forceinline__ void src(const Unit& u, USrc& s) const {
        const size_t blk = (size_t)u.pm * 65536 * 2;
        if (u.ex == 0) { s.a0 = (const char*)(ws + WS_QS) + blk; s.b0 = (const char*)(ws + WS_KS) + blk; }
        else if (u.ex == 1) { s.a0 = (const char*)(ws + WS_VT) + blk; s.b0 = (const char*)(ws + WS_KST) + blk; }
        else { const int gp = u.pm >> 6, cp = u.pm & 63; s.a0 = (const char*)(ws + WS_WSBLK) + (size_t)gp * 256 * 512; s.b0 = (const char*)(ws + WS_VNT) + ((size_t)gp * 16384 + cp * 256) * 512; }
        s.a1 = s.a0; s.b1 = s.b0;
    }
    __device__ __forceinline__ void epi_s(const Acc& acc, const Unit& u, int wr, int wc, int fr, int fq) const { const unsigned char* ws_base_ = ws;
        const int bh = u.pm >> 4, ch = u.pm & 15, b = bh >> 2, h = bh & 3; bf16_t* Pd = (bf16_t*)(ws + WS_P) + ((size_t)bh * SEQ + ch * LC) * 256; float* dp = (float*)(ws + WS_DENPART);
#pragma unroll
        for (int ai = 0; ai < 2; ++ai)
#pragma unroll
            for (int m = 0; m < 4; ++m) { const int l = ai * 128 + wr * 64 + m * 16 + fr; float rsum = 0.f;
#pragma unroll
                for (int bj = 0; bj < 2; ++bj) { const int s0 = bj * 128 + wc * 32 + 8 * fq; f32x4 v0 = acc[ai][bj][m][0], v1 = acc[ai][bj][m][1];
                    const float dl = (float)(l - s0 + 1);
#pragma unroll
                    for (int e = 0; e < 4; ++e) { v0[e] *= __builtin_amdgcn_fmed3f(dl - (float)e, 0.f, 1.f); v1[e] *= __builtin_amdgcn_fmed3f(dl - (float)(4 + e), 0.f, 1.f); }
                    rsum += (v0[0] + v0[1]) + (v0[2] + v0[3]) + (v1[0] + v1[1]) + (v1[2] + v1[3]);
                    wt16(ws_base_, Pd + (size_t)l * 256 + s0, pack8(v0, v1)); }
                rsum += __shfl_xor(rsum, 16); rsum += __shfl_xor(rsum, 32);
                if (fq == 0) wt4f(ws_base_, dp + ((size_t)(b * SEQ + ch * LC + l) * 4 + h) * 4 + wc, rsum); }
    }
    __device__ __forceinline__ void epi_kv(const Acc& acc, const Unit& u, int wr, int wc, int fr, int fq) const { const unsigned char* ws_base_ = ws;
        bf16_t* dst = (bf16_t*)(ws + WS_KVT) + (size_t)u.pm * 65536;
#pragma unroll
        for (int ai = 0; ai < 2; ++ai)
#pragma unroll
            for (int m = 0; m < 4; ++m) { bf16_t* rowp = dst + (size_t)(ai * 128 + wr * 64 + m * 16 + fr) * 256 + wc * 32 + 8 * fq;
#pragma unroll
                for (int bj = 0; bj < 2; ++bj) wt16(ws_base_, rowp + bj * 128, pack8(acc[ai][bj][m][0], acc[ai][bj][m][1])); }
    }
    __device__ __forceinline__ void epi_gm(const Acc& acc, const Unit& u, int wr, int wc, int fr, int fq) const { const unsigned char* ws_base_ = ws;
        const int gpi = u.pm >> 6, cp = u.pm & 63; const bf16_t* gu = (const bf16_t*)(ws + WS_GU); bf16_t* hg = (bf16_t*)(ws + WS_HG);
        u32x4 uu[2][4][2]; float bs[2][4];
#pragma unroll
        for (int ai = 0; ai < 2; ++ai) { const int g = 2 * gpi + ai;
#pragma unroll
            for (int m = 0; m < 4; ++m) { const int t = wr * 64 + m * 16 + fr; bs[ai][m] = b_s[g * 128 + t];
#pragma unroll
                for (int bj = 0; bj < 2; ++bj) uu[ai][m][bj] = *(const GAS u32x4*)(gu + (size_t)((cp * 2 + bj) * 128 + t) * GW + g * 128 + wc * 32 + 8 * fq); } }
#pragma unroll
        for (int ai = 0; ai < 2; ++ai) { const int g = 2 * gpi + ai;
#pragma unroll
            for (int m = 0; m < 4; ++m) { const int t = wr * 64 + m * 16 + fr;
#pragma unroll
                for (int bj = 0; bj < 2; ++bj) { const size_t o = (size_t)((cp * 2 + bj) * 128 + t) * GW + g * 128 + wc * 32 + 8 * fq; const u32x4 x = uu[ai][m][bj];
                    f32x4 v0 = acc[ai][bj][m][0] + bs[ai][m], v1 = acc[ai][bj][m][1] + bs[ai][m];
                    v0[0] *= bflo(x.x); v0[1] *= bfhi(x.x); v0[2] *= bflo(x.y); v0[3] *= bfhi(x.y); v1[0] *= bflo(x.z); v1[1] *= bfhi(x.z); v1[2] *= bflo(x.w); v1[3] *= bfhi(x.w);
                    wt16(ws_base_, hg + o, pack8(v0, v1)); } } }
    }
    __device__ __forceinline__ void epi(const Acc& acc, const Unit& u, int wr, int wc, int fr, int fq) const { asm volatile("" : "+v"(fr), "+v"(fq));
        if (u.ex == 0) epi_s(acc, u, wr, wc, fr, fq); else if (u.ex == 1) epi_kv(acc, u, wr, wc, fr, fq); else epi_gm(acc, u, wr, wc, fr, fq);
    }
};

__device__ __forceinline__ void p4_scan(Frame& F) {
    const unsigned char* ws_base_ = F.ws;
    DECL_TID;
    const float* gc = WSP(float, WS_GC);
    { const bf16_t* kv = WSP(const bf16_t, WS_KVT); bf16_t* cp = WSP(bf16_t, WS_CPT);
      const int gt = F.vcu * NTHR + tid, NGT = F.G * NTHR;
      for (int it = gt; it < 16 * 65536 / 8; it += NGT) { const int bh = it >> 13, ed = (it & 8191) * 8;
          u32x4 kq[NCH - 1]; float eg[NCH - 1];
#pragma unroll
          for (int c = 0; c < NCH - 1; ++c) { const size_t o = (size_t)(bh * NCH + c) * 65536 + ed; kq[c] = *(const GAS u32x4*)(kv + o); eg[c] = __expf(gc[bh * NCH + c]); }
          f32x4 C0 = (f32x4){0.f, 0.f, 0.f, 0.f}, C1 = C0;
#pragma unroll
          for (int c = 0; c < NCH; ++c) { const size_t o = (size_t)(bh * NCH + c) * 65536 + ed;
              wt16(ws_base_, cp + o, pack8(C0, C1));
              if (c < NCH - 1) { const u32x4 q = kq[c]; const f32x4 k0 = (f32x4){bflo(q.x), bfhi(q.x), bflo(q.y), bfhi(q.y)}, k1 = (f32x4){bflo(q.z), bfhi(q.z), bflo(q.w), bfhi(q.w)}; C0 = (C0 + k0) * eg[c]; C1 = (C1 + k1) * eg[c]; } } } }
    { LAS float* np = (LAS float*)F.lds;
      const float* nloc = WSP(float, WS_NLOC); const bf16_t* qs = WSP(const bf16_t, WS_QS); float* di = WSP(float, WS_DENINTER);
      for (int un = F.vcu; un < BATCH * NCH * 4; un += F.G) { const int b = un >> 6, c = (un >> 2) & 15, qt = un & 3;
          for (int i = tid; i < 1024; i += NTHR) { const int h = i >> 8, d = i & 255, bh = b * MH + h; float nl[NCH - 1], eg[NCH - 1];
#pragma unroll
              for (int cc = 0; cc < NCH - 1; ++cc) { const bool ok = cc < c; nl[cc] = ok ? nloc[(size_t)(bh * NCH + cc) * 256 + d] : 0.f; eg[cc] = ok ? __expf(gc[bh * NCH + cc]) : 1.f; }
              float n = 0.f;
#pragma unroll
              for (int cc = 0; cc < NCH - 1; ++cc) n = (n + nl[cc]) * eg[cc];
              np[i] = n; }
          __syncthreads();
          u32x4 qa[8], qb[8];
#pragma unroll
          for (int r = 0; r < 8; ++r) { const int l = qt * 64 + F.wave * 8 + r; const bf16_t* qp = qs + ((size_t)((b * MH + (lane >> 4)) * NCH + c) * 256 + l) * 256 + (lane & 15) * 16; qa[r] = *(const GAS u32x4*)qp; qb[r] = *(const GAS u32x4*)(qp + 8); }
          const LAS float* w = np + lane * 16;
#pragma unroll
          for (int r = 0; r < 8; ++r) { const int t = b * SEQ + c * LC + qt * 64 + F.wave * 8 + r; const u32x4 a = qa[r], bq = qb[r];
              float s = bflo(a.x) * w[0] + bfhi(a.x) * w[1] + bflo(a.y) * w[2] + bfhi(a.y) * w[3] + bflo(a.z) * w[4] + bfhi(a.z) * w[5] + bflo(a.w) * w[6] + bfhi(a.w) * w[7]
                      + bflo(bq.x) * w[8] + bfhi(bq.x) * w[9] + bflo(bq.y) * w[10] + bfhi(bq.y) * w[11] + bflo(bq.z) * w[12] + bfhi(bq.z) * w[13] + bflo(bq.w) * w[14] + bfhi(bq.w) * w[15];
              s += __shfl_xor(s, 1); s += __shfl_xor(s, 2); s += __shfl_xor(s, 4); s += __shfl_xor(s, 8);
              if ((lane & 15) == 0) wt4f(ws_base_, di + (size_t)t * 4 + (lane >> 4), s); }
          __syncthreads(); } }
}

struct ProbO {
    static constexpr int EPI_VM = 0; static constexpr bool PERM = true, AFTER_DRAIN = true, ALIGN = false, HAS_MID = false, GATHER = false; static constexpr int NSEG = 2; static constexpr unsigned lda0 = 512u, lda1 = 512u, ldb0 = 512u, ldb1 = 512u;
    int nt, ksw, mid_kt; int idx; unsigned char* ws; const float* gn_m;
    __device__ __forceinline__ bool next(int i, Unit& u) const { if (i > 0) return false; u.pm = idx >> 4; u.pn = idx & 15; u.ex = 0; return true; }
    __device__ __forceinline__ void src(const Unit& u, USrc& s) const {
        const int b = u.pm >> 2, h = u.pm & 3;
        s.a0 = (const char*)(ws + WS_P) + ((size_t)u.pm * SEQ + u.pn * LC) * 512;
        s.a1 = (const char*)(ws + WS_QS) + (size_t)(u.pm * NCH + u.pn) * 65536 * 2;
        s.b0 = (const char*)(ws + WS_VT) + (size_t)(u.pm * NCH + u.pn) * 65536 * 2;
        s.b1 = (const char*)(ws + WS_CPT) + (size_t)(u.pm * NCH + u.pn) * 65536 * 2;
    }
    __device__ __forceinline__ void fused(Acc& acc, const Unit& u, int wr, int wc, int fr, int fq, LAS unsigned char* lds, int wid, int lane) const { asm volatile("" : "+v"(fr), "+v"(fq)); const unsigned char* ws_base_ = ws; (void)ws_base_;
        const int b = u.pm >> 2, h = u.pm & 3, t0 = b * SEQ + u.pn * LC;
        const float* dp = (const float*)(ws + WS_DENPART); const float* di = (const float*)(ws + WS_DENINTER);
        LAS f32x2* Pst = (LAS f32x2*)lds;
        { f32x4 d4[2][4]; float dv[2][4];
#pragma unroll
          for (int ai = 0; ai < 2; ++ai)
#pragma unroll
            for (int m = 0; m < 4; ++m) { const size_t to = (size_t)(t0 + ai * 128 + wr * 64 + m * 16 + fr) * 4 + h; d4[ai][m] = *(const GAS f32x4*)(dp + to * 4); dv[ai][m] = di[to]; }
#pragma unroll
          for (int ai = 0; ai < 2; ++ai)
#pragma unroll
            for (int m = 0; m < 4; ++m) { const int l = ai * 128 + wr * 64 + m * 16 + fr;
                const float den = ((d4[ai][m][0] + d4[ai][m][1]) + (d4[ai][m][2] + d4[ai][m][3])) + dv[ai][m];
                const float rd = 1.0f / fmaxf(fabsf(den), 1.0f); float s = 0.f, q = 0.f;
#pragma unroll
                for (int bj = 0; bj < 2; ++bj)
#pragma unroll
                    for (int n = 0; n < 2; ++n) { f32x4 v = acc[ai][bj][m][n] * rd; acc[ai][bj][m][n] = v; s += (v[0] + v[1]) + (v[2] + v[3]); q += (v[0] * v[0] + v[1] * v[1]) + (v[2] * v[2] + v[3] * v[3]); }
                s += __shfl_xor(s, 16); s += __shfl_xor(s, 32); q += __shfl_xor(q, 16); q += __shfl_xor(q, 32);
                if (fq == 0) Pst[l * 4 + wc] = (f32x2){s, q}; } }
        asm volatile("s_waitcnt lgkmcnt(0)" ::: "memory"); __builtin_amdgcn_s_barrier(); asm volatile("" ::: "memory");
        const bf16_t* so = (const bf16_t*)(ws + WS_SO); bf16_t* hm = (bf16_t*)(ws + WS_HM);
        f32x4 gn[2][2];
#pragma unroll
        for (int bj = 0; bj < 2; ++bj) { const float* gp_ = gn_m + h * DH + bj * 128 + wc * 32 + 8 * fq; gn[bj][0] = *(const GAS f32x4*)gp_; gn[bj][1] = *(const GAS f32x4*)(gp_ + 4); }
        u32x4 gs[2][4][2];
#pragma unroll
        for (int ai = 0; ai < 2; ++ai)
#pragma unroll
            for (int m = 0; m < 4; ++m)
#pragma unroll
                for (int bj = 0; bj < 2; ++bj) gs[ai][m][bj] = *(const GAS u32x4*)(so + (size_t)(t0 + ai * 128 + wr * 64 + m * 16 + fr) * MW + h * DH + bj * 128 + wc * 32 + 8 * fq);
#pragma unroll
        for (int ai = 0; ai < 2; ++ai) {
#pragma unroll
            for (int m = 0; m < 4; ++m) { const int l = ai * 128 + wr * 64 + m * 16 + fr;
                const f32x2 p0 = Pst[l * 4 + 0], p1 = Pst[l * 4 + 1], p2 = Pst[l * 4 + 2], p3 = Pst[l * 4 + 3];
                const float mu = ((p0.x + p1.x) + (p2.x + p3.x)) * (1.0f / 256.0f), var = fmaxf(((p0.y + p1.y) + (p2.y + p3.y)) * (1.0f / 256.0f) - mu * mu, 0.f), rstd = 1.0f / sqrtf(var + EPS);
#pragma unroll
                for (int bj = 0; bj < 2; ++bj) { const size_t o = (size_t)(t0 + l) * MW + h * DH + bj * 128 + wc * 32 + 8 * fq; const u32x4 g = gs[ai][m][bj];
                    f32x4 v0 = (acc[ai][bj][m][0] - mu) * rstd * gn[bj][0], v1 = (acc[ai][bj][m][1] - mu) * rstd * gn[bj][1];
                    v0[0] *= bflo(g.x); v0[1] *= bfhi(g.x); v0[2] *= bflo(g.y); v0[3] *= bfhi(g.y); v1[0] *= bflo(g.z); v1[1] *= bfhi(g.z); v1[2] *= bflo(g.w); v1[3] *= bfhi(g.w);
                    wt16(ws_base_, hm + o, pack8(v0, v1)); } }
            asm volatile("" ::: "memory"); }
        asm volatile("s_waitcnt lgkmcnt(0)" ::: "memory"); __builtin_amdgcn_s_barrier(); asm volatile("" ::: "memory");
    }
    __device__ __forceinline__ void epi(const Acc&, const Unit&, int, int, int, int) const {}
};

struct ProbG23 {
    static constexpr int EPI_VM = 16; static constexpr bool PERM = true, AFTER_DRAIN = false, ALIGN = true, HAS_MID = true, GATHER = false; static constexpr int NSEG = 2; static constexpr unsigned lda0 = 2048u, lda1 = 2048u, ldb0 = 4096u, ldb1 = 4096u;
    int nt, ksw, mid_kt; eng::StaticOrder S; unsigned char* ws;
    __device__ __forceinline__ bool next(int i, Unit& u) const { return S.next(i, u); }
    __device__ __forceinline__ void src(const Unit& u, USrc& s) const {
        s.a0 = (const char*)(ws + WS_HM) + (size_t)u.pm * 256 * 2048; s.a1 = (const char*)(ws + WS_HG) + (size_t)u.pm * 256 * 2048;
        s.b0 = (const char*)(ws + WS_WB) + (size_t)u.pn * 256 * 4096; s.b1 = s.b0 + 2048;
    }
    __device__ __forceinline__ void mid(Acc& acc, u32x2 (&keep)[2][4][2], const Unit& u, int wr, int wc, int fr, int fq) const { asm volatile("" : "+v"(fr), "+v"(fq)); const unsigned char* ws_base_ = ws; (void)ws_base_;
        const unsigned char* gmt = ws + WS_GATES + (size_t)(u.pm * 16 + u.pn) * 65536; const unsigned char* ggt = gmt + (size_t)8 * 65536;
        const bool odd = (fq & 1) != 0; const int lofs = (odd ? 512 : 0) + fr * 32 + (fq & ~1) * 8;
#define U8F(w, j) ((float)(((w) >> (8 * (j))) & 0xffu))
        u32x4 gmLL[2][4], ggLL[2][4];
#pragma unroll
        for (int ai = 0; ai < 2; ++ai)
#pragma unroll
            for (int m = 0; m < 4; ++m) { const int q = ((ai * 2 + wr) * 4 + m) * 4 + wc; gmLL[ai][m] = *(const GAS u32x4*)(gmt + q * 1024 + lofs); ggLL[ai][m] = *(const GAS u32x4*)(ggt + q * 1024 + lofs); }
#pragma unroll
        for (int ai = 0; ai < 2; ++ai) { u32x4 gmL[4], ggL[4];
#pragma unroll
            for (int m = 0; m < 4; ++m) { gmL[m] = gmLL[ai][m]; ggL[m] = ggLL[ai][m]; }
            u32x2 gm[4][2], gg[4][2];
#pragma unroll
            for (int m = 0; m < 4; ++m) {
                { const u32x4 L = gmL[m]; const unsigned sx = odd ? L.x : L.z, sy = odd ? L.y : L.w; const unsigned px = (unsigned)__shfl_xor((int)sx, 16), py = (unsigned)__shfl_xor((int)sy, 16);
                  if (!odd) { gm[m][0] = (u32x2){L.x, L.y}; gm[m][1] = (u32x2){px, py}; } else { gm[m][0] = (u32x2){px, py}; gm[m][1] = (u32x2){L.z, L.w}; } }
                { const u32x4 L = ggL[m]; const unsigned sx = odd ? L.x : L.z, sy = odd ? L.y : L.w; const unsigned px = (unsigned)__shfl_xor((int)sx, 16), py = (unsigned)__shfl_xor((int)sy, 16);
                  if (!odd) { gg[m][0] = (u32x2){L.x, L.y}; gg[m][1] = (u32x2){px, py}; } else { gg[m][0] = (u32x2){px, py}; gg[m][1] = (u32x2){L.z, L.w}; } } }
#pragma unroll
            for (int m = 0; m < 4; ++m)
#pragma unroll
                for (int bj = 0; bj < 2; ++bj) { const u32x2 a = gm[m][bj], c = gg[m][bj]; f32x4 r0, r1;
                    r0[0] = U8F(a.x, 0) * __builtin_amdgcn_rcpf(U8F(c.x, 0)); r0[1] = U8F(a.x, 1) * __builtin_amdgcn_rcpf(U8F(c.x, 1));
                    r0[2] = U8F(a.x, 2) * __builtin_amdgcn_rcpf(U8F(c.x, 2)); r0[3] = U8F(a.x, 3) * __builtin_amdgcn_rcpf(U8F(c.x, 3));
                    r1[0] = U8F(a.y, 0) * __builtin_amdgcn_rcpf(U8F(c.y, 0)); r1[1] = U8F(a.y, 1) * __builtin_amdgcn_rcpf(U8F(c.y, 1));
                    r1[2] = U8F(a.y, 2) * __builtin_amdgcn_rcpf(U8F(c.y, 2)); r1[3] = U8F(a.y, 3) * __builtin_amdgcn_rcpf(U8F(c.y, 3));
                    acc[ai][bj][m][0] *= r0; acc[ai][bj][m][1] *= r1; keep[ai][m][bj] = c; }
            asm volatile("" ::: "memory"); }
    }
    __device__ __forceinline__ void epi(const Acc&, const Unit&, int, int, int, int) const {}
    __device__ __forceinline__ void epi_keep(const Acc& acc, const u32x2 (&gg)[2][4][2], const Unit& u, int wr, int wc, int fr, int fq) const { asm volatile("" : "+v"(fr), "+v"(fq)); const unsigned char* ws_base_ = ws; (void)ws_base_;
        bf16_t* mg = (bf16_t*)(ws + WS_MERGED);
        constexpr float I255 = 1.0f / 255.0f;
#pragma unroll
        for (int ai = 0; ai < 2; ++ai) {
#pragma unroll
            for (int m = 0; m < 4; ++m) { const int row = u.pm * 256 + ai * 128 + wr * 64 + m * 16 + fr; const int col = u.pn * 256 + wc * 32 + 8 * fq;
#pragma unroll
                for (int bj = 0; bj < 2; ++bj) { const u32x2 c = gg[ai][m][bj]; f32x4 v0 = acc[ai][bj][m][0], v1 = acc[ai][bj][m][1];
                    v0[0] *= U8F(c.x, 0) * I255; v0[1] *= U8F(c.x, 1) * I255; v0[2] *= U8F(c.x, 2) * I255; v0[3] *= U8F(c.x, 3) * I255;
                    v1[0] *= U8F(c.y, 0) * I255; v1[1] *= U8F(c.y, 1) * I255; v1[2] *= U8F(c.y, 2) * I255; v1[3] *= U8F(c.y, 3) * I255;
                    wt16(ws_base_, mg + (size_t)row * D + col + bj * 128, pack8(v0, v1)); } }
            asm volatile("" ::: "memory"); }
    }
#undef U8F
};

struct ProbG4 {
    static constexpr int EPI_VM = 16; static constexpr bool PERM = true, AFTER_DRAIN = false, ALIGN = true, HAS_MID = false, GATHER = false; static constexpr int NSEG = 1; static constexpr unsigned lda0 = 4096u, lda1 = 4096u, ldb0 = 4096u, ldb1 = 4096u;
    int nt, ksw, mid_kt; eng::StaticOrder S; unsigned char* ws;
    __device__ __forceinline__ bool next(int i, Unit& u) const { return S.next(i, u); }
    __device__ __forceinline__ void src(const Unit& u, USrc& s) const {
        s.a0 = s.a1 = (const char*)(ws + WS_MERGED) + (size_t)u.pm * 256 * 4096; s.b0 = s.b1 = (const char*)(ws + WS_WOUT) + (size_t)u.pn * 256 * 4096;
    }
    __device__ __forceinline__ void epi(const Acc& acc, const Unit& u, int wr, int wc, int fr, int fq) const { asm volatile("" : "+v"(fr), "+v"(fq)); const unsigned char* ws_base_ = ws; (void)ws_base_;
        bf16_t* dst = (bf16_t*)(ws + WS_MIX);
        const int row0 = u.pm * 256 + wr * 64 + fr, col0 = u.pn * 256 + wc * 32 + 8 * fq;
#pragma unroll
        for (int ai = 0; ai < 2; ++ai)
#pragma unroll
            for (int m = 0; m < 4; ++m) { bf16_t* rowp = dst + (size_t)(row0 + ai * 128 + m * 16) * D + col0;
#pragma unroll
                for (int bj = 0; bj < 2; ++bj) wt16(ws_base_, rowp + bj * 128, pack8(acc[ai][bj][m][0], acc[ai][bj][m][1])); }
    }
};

__device__ __forceinline__ void p8_router(Frame& F, const Args& args) {
    const unsigned char* ws_base_ = F.ws;
    DECL_TID;
    const float* g_ffn = INP(15);
    { LAS float* scr = (LAS float*)(F.lds + F.wave * TSCR_BYTES);
      const int gw = F.vcu * NWAVES + F.wave, NGW = F.G * NWAVES;
      constexpr int I_13 = 32 * 32 * 16, I_2 = 32 * 8 * 32;
      const int sl = lane & 15, grp2 = sl >> 3, isw3 = (sl >> 2) & 1, c4 = (sl & 3) * 4;
      for (int rep2 = 0; rep2 < (((REPEAT_MASK >> 14) & 1) ? 2 : 1); ++rep2)
      for (int it = gw; it < I_13 + I_2; it += NGW) {
          if (it < I_13) { const int e = it >> 9, r = it & 511, kb = r & 31, nb = r >> 5;
              const float* wsrc = isw3 ? INP(21) : INP(20);
              transpose_item(F.ws, wsrc + (size_t)e * D * DE + (nb * 2 + grp2) * 16 + c4, DE, g_ffn, kb * 64, WSP(bf16_t, WS_W13) + ((size_t)e * 1024 + nb * 64) * D + kb * 64, D, scr, lane); }
          else { const int r2 = it - I_13, e = r2 >> 8, r = r2 & 255, kb = r & 7, nb = r >> 3;
              transpose_item(F.ws, INP(22) + (size_t)e * DE * D + nb * 64 + (lane & 15) * 4, D, nullptr, kb * 64, WSP(bf16_t, WS_W2) + ((size_t)e * D + nb * 64) * DE + kb * 64, DE, scr, lane); }
      } }
    __syncthreads();
    LAS bf16_t* we = (LAS bf16_t*)F.lds;
    { const float* w_re = INP(18);
      for (int idx = tid; idx < D * 32 / 2; idx += NTHR) { const int k = idx >> 4, e2 = (idx & 15) * 2; const float g = g_ffn[k];
          const f32x2 w = *(const GAS f32x2*)(w_re + (size_t)k * 32 + e2); we[e2 * D + k] = (bf16_t)f2bf(w.x * g); we[(e2 + 1) * D + k] = (bf16_t)f2bf(w.y * g); } }
    LAS int* s_e = (LAS int*)(F.lds + XTR_OFF);
    LAS float* s_w = (LAS float*)(F.lds + XTR_OFF + 512);
    LAS int* s_cnt = (LAS int*)(F.lds + XTR_OFF + 1024);
    LAS int* s_base = s_cnt + 32;
    LAS int* s_rank = s_cnt + 64;
    LAS bf16_t* wgl = (LAS bf16_t*)(F.lds + XTR_OFF + 4096);
    { const float* w_rg = INP(16);
      for (int k = tid; k < D; k += NTHR) { const f32x4 w = *(const GAS f32x4*)(w_rg + (size_t)k * 4); const float g = g_ffn[k];
          wgl[0 * D + k] = (bf16_t)f2bf(w[0] * g); wgl[1 * D + k] = (bf16_t)f2bf(w[1] * g); wgl[2 * D + k] = (bf16_t)f2bf(w[2] * g); wgl[3 * D + k] = (bf16_t)f2bf(w[3] * g); } }
    const float* b_rg = INP(17); const float* b_re = INP(19);
    const float* xin = INP(0); const bf16_t* mix = WSP(const bf16_t, WS_MIX); bf16_t* x1b = WSP(bf16_t, WS_X1B);
    for (int blk = F.vcu; blk < M / 64; blk += F.G) {
        if (tid < 32) s_cnt[tid] = 0;
        __syncthreads();
        f32x4 nx[8]; u32x4 nm[4];
        { const int t = blk * 64 + F.wave * 8; const float* xrow = xin + (size_t)t * D; const bf16_t* mrow = mix + (size_t)t * D;
#pragma unroll
          for (int p = 0; p < 4; ++p) { nm[p] = *(const GAS u32x4*)(mrow + 512 * p + 8 * lane); nx[2 * p] = *(const GAS f32x4*)(xrow + E0(2 * p)); nx[2 * p + 1] = *(const GAS f32x4*)(xrow + E0(2 * p + 1)); } }
#pragma unroll 1
        for (int r = 0; r < 8; ++r) { const int tl = F.wave * 8 + r, t = blk * 64 + tl;
            bf16_t* xbrow = x1b + (size_t)t * D;
            f32x4 v[8]; float ss = 0.f, g0 = 0.f, g1 = 0.f, g2 = 0.f, g3 = 0.f;
#pragma unroll
            for (int p = 0; p < 4; ++p) { const u32x4 mm = nm[p]; f32x4 a = nx[2 * p], b = nx[2 * p + 1];
                a[0] += bflo(mm.x); a[1] += bfhi(mm.x); a[2] += bflo(mm.y); a[3] += bfhi(mm.y); b[0] += bflo(mm.z); b[1] += bfhi(mm.z); b[2] += bflo(mm.w); b[3] += bfhi(mm.w);
                v[2 * p] = a; v[2 * p + 1] = b; }
            if (r < 7) { const float* xrow = xin + (size_t)(t + 1) * D; const bf16_t* mrow = mix + (size_t)(t + 1) * D;
#pragma unroll
                for (int p = 0; p < 4; ++p) { nm[p] = *(const GAS u32x4*)(mrow + 512 * p + 8 * lane); nx[2 * p] = *(const GAS f32x4*)(xrow + E0(2 * p)); nx[2 * p + 1] = *(const GAS f32x4*)(xrow + E0(2 * p + 1)); } }
#pragma unroll
            for (int j = 0; j < 8; ++j) ss += (v[j][0] * v[j][0] + v[j][1] * v[j][1]) + (v[j][2] * v[j][2] + v[j][3] * v[j][3]);
            float gacc[4];
#pragma unroll
            for (int g = 0; g < 4; ++g) { const LAS bf16_t* wp = wgl + g * D + 8 * lane; float a = 0.f;
#pragma unroll
                for (int p = 0; p < 4; ++p) { const u32x4 w = *(const LAS u32x4*)(wp + 512 * p); a += ((v[2 * p][0] * bflo(w.x) + v[2 * p][1] * bfhi(w.x)) + (v[2 * p][2] * bflo(w.y) + v[2 * p][3] * bfhi(w.y))) + ((v[2 * p + 1][0] * bflo(w.z) + v[2 * p + 1][1] * bfhi(w.z)) + (v[2 * p + 1][2] * bflo(w.w) + v[2 * p + 1][3] * bfhi(w.w))); }
                gacc[g] = a; }
            g0 = gacc[0]; g1 = gacc[1]; g2 = gacc[2]; g3 = gacc[3];
            ss = wave_sum(ss); g0 = wave_sum(g0); g1 = wave_sum(g1); g2 = wave_sum(g2); g3 = wave_sum(g3);
            const float rr = 1.0f / sqrtf(ss * (1.0f / D) + EPS);
#pragma unroll
            for (int p = 0; p < 4; ++p) wt16(ws_base_, xbrow + 512 * p + 8 * lane, pack8(v[2 * p] * rr, v[2 * p + 1] * rr));
            float gl[4] = {rr * g0 + b_rg[0], rr * g1 + b_rg[1], rr * g2 + b_rg[2], rr * g3 + b_rg[3]};
            int grp = 0; float gmax = gl[0];
#pragma unroll
            for (int g = 1; g < 4; ++g) if (gl[g] > gmax) { gmax = gl[g]; grp = g; }
            const float pg = 1.0f / ((__expf(gl[0] - gmax) + __expf(gl[1] - gmax)) + (__expf(gl[2] - gmax) + __expf(gl[3] - gmax)));
            float el[8];
#pragma unroll
            for (int e = 0; e < 8; ++e) { const LAS bf16_t* wp = we + (size_t)(grp * 8 + e) * D + 8 * lane; float a = 0.f;
#pragma unroll
                for (int p = 0; p < 4; ++p) { const u32x4 w = *(const LAS u32x4*)(wp + 512 * p); a += ((v[2 * p][0] * bflo(w.x) + v[2 * p][1] * bfhi(w.x)) + (v[2 * p][2] * bflo(w.y) + v[2 * p][3] * bfhi(w.y))) + ((v[2 * p + 1][0] * bflo(w.z) + v[2 * p + 1][1] * bfhi(w.z)) + (v[2 * p + 1][2] * bflo(w.w) + v[2 * p + 1][3] * bfhi(w.w))); }
                el[e] = rr * wave_sum(a) + b_re[grp * 8 + e]; }
            int i0 = 0; float m0 = el[0];
#pragma unroll
            for (int e = 1; e < 8; ++e) if (el[e] > m0) { m0 = el[e]; i0 = e; }
            int i1 = -1; float m1 = -3.0e38f;
#pragma unroll
            for (int e = 0; e < 8; ++e) if (e != i0 && el[e] > m1) { m1 = el[e]; i1 = e; }
            const float e1 = __expf(m1 - m0), w0 = pg / (1.0f + e1), w1 = pg * e1 / (1.0f + e1);
            if (lane == 0) { s_e[tl * 2] = grp * 8 + i0; s_e[tl * 2 + 1] = grp * 8 + i1; s_w[tl * 2] = w0; s_w[tl * 2 + 1] = w1; wt4f(ws_base_, WSP(float, WS_R1) + t, rr); }
        }
        __syncthreads();
        if (tid < 128) s_rank[tid] = atomicAdd((int*)&s_cnt[s_e[tid]], 1);
        __syncthreads();
        { const int t2 = F.wave * 64 + lane_id();
          if (t2 < 32) { const int c = s_cnt[t2]; s_base[t2] = c > 0 ? (int)__hip_atomic_fetch_add((unsigned*)(F.ctl + CW_CNT + 64 * t2), (unsigned)c, RLX_AGENT) : 0; } }
        __syncthreads();
        if (tid < 128) { const int e = s_e[tid], pos = s_base[e] + s_rank[tid]; wt4(ws_base_, WSP(int, WS_LIST) + (size_t)e * M + pos, (unsigned)((blk * 64 + (tid >> 1)) * 2 + (tid & 1))); wt4f(ws_base_, WSP(float, WS_LISTW) + (size_t)e * M + pos, s_w[tid]); }
        __syncthreads();
    }
}

__device__ __forceinline__ void moe_table(Frame& F, LAS int* tstart, LAS int* cnt) {
    DECL_TID;
    if (tid < 32) cnt[tid] = (int)__hip_atomic_load((unsigned*)(F.ctl + CW_CNT + 64 * tid), RLX_AGENT);
    __syncthreads();
    if (tid == 0) { int a = 0; for (int e = 0; e < 32; ++e) { tstart[e] = a; a += (cnt[e] + 255) >> 8; } tstart[32] = a; }
    __syncthreads();
}
__device__ __forceinline__ int moe_expert_of(const LAS int* tstart, int rt) { int e = 0; while (e < 31 && tstart[e + 1] <= rt) ++e; return e; }

struct ProbMU {
    static constexpr int EPI_VM = 8; static constexpr bool PERM = false, AFTER_DRAIN = false, ALIGN = true, HAS_MID = false, GATHER = true; static constexpr int NSEG = 1; static constexpr unsigned lda0 = 4096u, lda1 = 4096u, ldb0 = 4096u, ldb1 = 4096u;
    int nt, ksw, mid_kt; int G, c0, nun; unsigned char* ws; const LAS int* tstart; const LAS int* cnt;
    __device__ __forceinline__ bool next(int i, Unit& u) const { const int idx = i * G + c0; if (idx >= nun) return false;
        u.pm = idx >> 2; u.pn = idx & 3; u.ex = __builtin_amdgcn_readfirstlane(moe_expert_of(tstart, u.pm)); return true; }
    __device__ __forceinline__ void src(const Unit& u, USrc& s) const {
        s.a0 = s.a1 = (const char*)(ws + WS_X1B);
        s.b0 = s.b1 = (const char*)(ws + WS_W13) + ((size_t)u.ex * 1024 + u.pn * 256) * 4096;
    }
    __device__ __forceinline__ int tok_of(const Unit& u, int r) const { const int pos = (u.pm - __builtin_amdgcn_readfirstlane(tstart[u.ex])) * 256 + r;
        return pos < __builtin_amdgcn_readfirstlane(cnt[u.ex]) ? (((const int*)(ws + WS_LIST))[(size_t)u.ex * M + pos] >> 1) : 0; }
    __device__ __forceinline__ unsigned arow(const Unit& u, int r) const { return (unsigned)tok_of(u, r) * 4096u; }
    __device__ __forceinline__ void epi(const Acc& acc, const Unit& u, int wr, int wc, int fr, int fq) const { asm volatile("" : "+v"(fr), "+v"(fq)); const unsigned char* ws_base_ = ws; (void)ws_base_;
        bf16_t* H = (bf16_t*)(ws + WS_H);
#pragma unroll
        for (int ai = 0; ai < 2; ++ai)
#pragma unroll
            for (int m = 0; m < 4; ++m) { const int r = ai * 128 + wr * 64 + m * 16 + fr;
                u32x2 w0, w1;
                { const f32x4 a = acc[ai][0][m][0], bq = acc[ai][0][m][1]; w0.x = cvt_pk_bf16(fsilu(a[0]) * bq[0], fsilu(a[1]) * bq[1]); w0.y = cvt_pk_bf16(fsilu(a[2]) * bq[2], fsilu(a[3]) * bq[3]); }
                { const f32x4 a = acc[ai][1][m][0], bq = acc[ai][1][m][1]; w1.x = cvt_pk_bf16(fsilu(a[0]) * bq[0], fsilu(a[1]) * bq[1]); w1.y = cvt_pk_bf16(fsilu(a[2]) * bq[2], fsilu(a[3]) * bq[3]); }
                const bool odd = (fq & 1) != 0;
                const unsigned sx = odd ? w0.x : w1.x, sy = odd ? w0.y : w1.y;
                const unsigned px = (unsigned)__shfl_xor((int)sx, 16), py = (unsigned)__shfl_xor((int)sy, 16);
                u32x4 o; if (!odd) { o.x = w0.x; o.y = w0.y; o.z = px; o.w = py; } else { o.x = px; o.y = py; o.z = w1.x; o.w = w1.y; }
                bf16_t* rowp = H + (size_t)(u.pm * 256 + r) * DE + u.pn * 128 + wc * 16 + 4 * (fq & ~1) + (odd ? 64 : 0);
                wt16(ws_base_, rowp, o); if (m & 1) asm volatile("" ::: "memory"); }
    }
};
struct ProbMD {
    static constexpr int EPI_VM = 16; static constexpr bool PERM = true, AFTER_DRAIN = false, ALIGN = true, HAS_MID = false, GATHER = false; static constexpr int NSEG = 1; static constexpr unsigned lda0 = 1024u, lda1 = 1024u, ldb0 = 1024u, ldb1 = 1024u;
    int nt, ksw, mid_kt; int G, c0; unsigned char* ws; const LAS int* tstart; const LAS int* cnt;
    __device__ __forceinline__ bool next(int i, Unit& u) const { const int idx = i * G + c0; if (idx >= __builtin_amdgcn_readfirstlane(tstart[32]) * 8) return false;
        const int rt = idx >> 3; u.pm = rt; u.pn = idx & 7; u.ex = __builtin_amdgcn_readfirstlane(moe_expert_of(tstart, rt)); return true; }
    __device__ __forceinline__ void src(const Unit& u, USrc& s) const {
        s.a0 = s.a1 = (const char*)(ws + WS_H) + (size_t)u.pm * 256 * 1024;
        s.b0 = s.b1 = (const char*)(ws + WS_W2) + ((size_t)u.ex * D + u.pn * 256) * 1024;
    }
    __device__ __forceinline__ void epi(const Acc& acc, const Unit& u, int wr, int wc, int fr, int fq) const { asm volatile("" : "+v"(fr), "+v"(fq)); const unsigned char* ws_base_ = ws; (void)ws_base_;
        bf16_t* Y = (bf16_t*)(ws + WS_Y); const int* list = (const int*)(ws + WS_LIST); const float* lw = (const float*)(ws + WS_LISTW);
        const int j = u.pm - __builtin_amdgcn_readfirstlane(tstart[u.ex]), n = __builtin_amdgcn_readfirstlane(cnt[u.ex]);
        int t2[2][4]; float wv[2][4];
#pragma unroll
        for (int ai = 0; ai < 2; ++ai)
#pragma unroll
            for (int m = 0; m < 4; ++m) { const int pos = j * 256 + ai * 128 + wr * 64 + m * 16 + fr; const bool ok = pos < n;
                t2[ai][m] = ok ? list[(size_t)u.ex * M + pos] : -1; wv[ai][m] = ok ? lw[(size_t)u.ex * M + pos] : 0.f; }
#pragma unroll
        for (int ai = 0; ai < 2; ++ai)
#pragma unroll
            for (int m = 0; m < 4; ++m) {
                const bool ok = t2[ai][m] >= 0; const float w = wv[ai][m];
                bf16_t* rowp = ok ? Y + (size_t)t2[ai][m] * D + u.pn * 256 + wc * 32 + 8 * fq : (bf16_t*)(ws + WS_DUMP) + ((wr * 4 + wc) * 64 + fq * 16 + fr) * 8;
                const int bjs = ok ? 128 : 4096;
#pragma unroll
                for (int bj = 0; bj < 2; ++bj) wt16(ws_base_, rowp + bj * bjs, pack8(acc[ai][bj][m][0] * w, acc[ai][bj][m][1] * w)); }
    }
};

__device__ __forceinline__ void p11_combine(Frame& F) {
    const unsigned char* ws_base_ = F.ws;
    DECL_TID; const int gw = F.vcu * NWAVES + F.wave, NGW = F.G * NWAVES;
    const bf16_t* Y = WSP(const bf16_t, WS_Y); bf16_t* xb = WSP(bf16_t, WS_X1B); float* r2 = WSP(float, WS_R2); const float* r1 = WSP(const float, WS_R1);
    for (int m = gw; m < M; m += NGW) { const float q = 1.0f / r1[m];
        const bf16_t* y0 = Y + (size_t)(2 * m) * D + 8 * lane; const bf16_t* y1 = Y + (size_t)(2 * m + 1) * D + 8 * lane; bf16_t* ob = xb + (size_t)m * D + 8 * lane;
        float ss = 0.f;
#pragma unroll
        for (int p = 0; p < 4; ++p) { const u32x4 x = *(const GAS u32x4*)(ob + 512 * p), a = *(const GAS u32x4*)(y0 + 512 * p), b = *(const GAS u32x4*)(y1 + 512 * p); f32x4 v0, v1;
            v0[0] = bflo(x.x) * q + (bflo(a.x) + bflo(b.x)); v0[1] = bfhi(x.x) * q + (bfhi(a.x) + bfhi(b.x)); v0[2] = bflo(x.y) * q + (bflo(a.y) + bflo(b.y)); v0[3] = bfhi(x.y) * q + (bfhi(a.y) + bfhi(b.y));
            v1[0] = bflo(x.z) * q + (bflo(a.z) + bflo(b.z)); v1[1] = bfhi(x.z) * q + (bfhi(a.z) + bfhi(b.z)); v1[2] = bflo(x.w) * q + (bflo(a.w) + bflo(b.w)); v1[3] = bfhi(x.w) * q + (bfhi(a.w) + bfhi(b.w));
            wt16(ws_base_, ob + 512 * p, pack8(v0, v1));
            ss += ((v0[0] * v0[0] + v0[1] * v0[1]) + (v0[2] * v0[2] + v0[3] * v0[3])) + ((v1[0] * v1[0] + v1[1] * v1[1]) + (v1[2] * v1[2] + v1[3] * v1[3])); }
        ss = wave_sum(ss);
        if (lane == 0) wt4f(ws_base_, r2 + m, 1.0f / sqrtf(ss * (1.0f / D) + EPS));
    }
}

struct ProbPG {
    static constexpr int EPI_VM = 16; static constexpr bool PERM = true, AFTER_DRAIN = false, ALIGN = true, HAS_MID = false, GATHER = false; static constexpr int NSEG = 1; static constexpr unsigned lda0 = 4096u, lda1 = 4096u, ldb0 = 4096u, ldb1 = 4096u;
    int nt, ksw, mid_kt; eng::StaticOrder S; unsigned char* ws;
    __device__ __forceinline__ bool next(int i, Unit& u) const { return S.next(i, u); }
    __device__ __forceinline__ void src(const Unit& u, USrc& s) const {
        s.a0 = s.a1 = (const char*)(ws + WS_X1B) + (size_t)u.pm * 256 * 4096; s.b0 = s.b1 = (const char*)(ws + WS_WPG) + (size_t)u.pn * 256 * 4096;
    }
    __device__ __forceinline__ void epi(const Acc& acc, const Unit& u, int wr, int wc, int fr, int fq) const { asm volatile("" : "+v"(fr), "+v"(fq)); const unsigned char* ws_base_ = ws; (void)ws_base_;
        const float* r2 = (const float*)(ws + WS_R2); const bf16_t* ple = (const bf16_t*)(ws + WS_PLEV) + (size_t)(u.pm * 8 + u.pn) * 65536 + fr * 32 + fq * 8; bf16_t* gp = (bf16_t*)(ws + WS_GP);
        u32x4 pv[2][4][2]; float rs[2][4];
#pragma unroll
        for (int ai = 0; ai < 2; ++ai)
#pragma unroll
            for (int m = 0; m < 4; ++m) { const int row = u.pm * 256 + ai * 128 + wr * 64 + m * 16 + fr; rs[ai][m] = r2[row];
#pragma unroll
                for (int bj = 0; bj < 2; ++bj) pv[ai][m][bj] = *(const GAS u32x4*)(ple + ((((ai * 2 + wr) * 4 + m) * 4 + wc) * 2 + bj) * 512); }
#pragma unroll
        for (int ai = 0; ai < 2; ++ai) {
#pragma unroll
            for (int m = 0; m < 4; ++m) { const size_t ro = (size_t)(u.pm * 256 + ai * 128 + wr * 64 + m * 16 + fr) * D + u.pn * 256 + wc * 32 + 8 * fq;
#pragma unroll
                for (int bj = 0; bj < 2; ++bj) { const u32x4 p = pv[ai][m][bj]; f32x4 v0 = act4<1>(acc[ai][bj][m][0] * rs[ai][m]), v1 = act4<1>(acc[ai][bj][m][1] * rs[ai][m]);
                    v0[0] *= bflo(p.x); v0[1] *= bfhi(p.x); v0[2] *= bflo(p.y); v0[3] *= bfhi(p.y); v1[0] *= bflo(p.z); v1[1] *= bfhi(p.z); v1[2] *= bflo(p.w); v1[3] *= bfhi(p.w);
                    wt16(ws_base_, gp + ro + bj * 128, pack8(v0, v1)); } }
            asm volatile("" ::: "memory"); }
    }
};

__device__ __forceinline__ void p13_final(Frame& F, const Args& args) {
    DECL_TID; const int gw = F.vcu * NWAVES + F.wave, NGW = F.G * NWAVES;
    const bf16_t* gp = WSP(const bf16_t, WS_GP); const float* gf = INP(26);
    f32x4 g[8];
#pragma unroll
    for (int j = 0; j < 8; ++j) g[j] = *(const GAS f32x4*)(gf + E0(j));
    for (int m = gw; m < M; m += NGW) {
        float* orow = F.out + (size_t)m * D; const bf16_t* pr = gp + (size_t)m * D + 8 * lane; const bf16_t* xq = WSP(const bf16_t, WS_X1B) + (size_t)m * D + 8 * lane;
        f32x4 v[8]; float ss = 0.f;
#pragma unroll
        for (int p = 0; p < 4; ++p) { const u32x4 a = *(const GAS u32x4*)(pr + 512 * p), x = *(const GAS u32x4*)(xq + 512 * p);
            v[2 * p][0] = bflo(x.x) + bflo(a.x); v[2 * p][1] = bfhi(x.x) + bfhi(a.x); v[2 * p][2] = bflo(x.y) + bflo(a.y); v[2 * p][3] = bfhi(x.y) + bfhi(a.y);
            v[2 * p + 1][0] = bflo(x.z) + bflo(a.z); v[2 * p + 1][1] = bfhi(x.z) + bfhi(a.z); v[2 * p + 1][2] = bflo(x.w) + bflo(a.w); v[2 * p + 1][3] = bfhi(x.w) + bfhi(a.w); }
#pragma unroll
        for (int j = 0; j < 8; ++j) ss += (v[j][0] * v[j][0] + v[j][1] * v[j][1]) + (v[j][2] * v[j][2] + v[j][3] * v[j][3]);
        ss = wave_sum(ss);
        const float r = 1.0f / sqrtf(ss * (1.0f / D) + EPS);
#pragma unroll
        for (int j = 0; j < 8; ++j) *(GAS f32x4*)(orow + E0(j)) = v[j] * r * g[j];
    }
}

__global__ void __launch_bounds__(NTHR, 2) mk_fwd(Args args) {
    extern __shared__ __attribute__((aligned(16))) unsigned char lds[];
    Frame F;
    F.lds = (LAS unsigned char*)lds;
    F.MISC = (volatile LAS unsigned*)(F.lds + MISC_OFF);
    F.wave = __builtin_amdgcn_readfirstlane((int)threadIdx.x >> 6);
    F.G = gridDim.x; { const int bx = blockIdx.x; F.vcu = (F.G % 8 == 0) ? (bx % 8) * (F.G / 8) + bx / 8 : bx; }
    F.ws = args.ws; F.out = args.out; F.ctl = (gu32*)(args.ws + WS_CTL);
    for (int u = (int)threadIdx.x; u < (LDS_BYTES - LDSCTL_OFF) / 4; u += NTHR) ((LAS unsigned*)(F.lds + LDSCTL_OFF))[u] = 0u;
    __syncthreads();
    XcdBarrier bar; bar.bar = (unsigned*)(F.ctl + CW_BAR); bar.x = 0; bar.st = nullptr;
    if (N_LAUNCHES == 1) bar = xcd_barrier_post((unsigned*)(F.ctl + CW_BAR), F.MISC + 8);
    const int lo = args.ph_lo, hi = args.ph_hi;
#define IN(k) (((PHASE_MASK >> (k)) & 1) && lo <= (k) && (k) < hi)
#define SEAM(k) do { if (IN(k) && IN((k) + 1)) xcd_barrier(bar); } while (0)
#define REP(k) for (int rep_ = 0; rep_ < (((REPEAT_MASK >> (k)) & 1) ? 2 : 1); ++rep_)
    LAS unsigned char* ring = F.lds;
    const int bx = (int)blockIdx.x;

    REP(0) if (IN(0)) { if (rep_) xcd_barrier(bar); p0_prologue(F, args); } SEAM(0);
    REP(1) if (IN(1)) { if (rep_) xcd_barrier(bar);
        { ProbG1 P; P.nt = 32; P.ksw = 1 << 20; P.mid_kt = -1; P.S.init(M, NG1, F.G, bx); P.ws = F.ws; eng::gemm_phase(ring, P, F.wave); }
        { ProbPU P; P.nt = 4; P.ksw = 1 << 20; P.mid_kt = -1; P.S.init(M, D, F.G, bx); P.ws = F.ws; eng::gemm_phase(ring, P, F.wave); }
    } SEAM(1);
    REP(2) if (IN(2)) { if (rep_) xcd_barrier(bar); p2_elementwise(F, args, 0);
        asm volatile("s_waitcnt vmcnt(0)" ::: "memory"); __syncthreads();
        if (threadIdx.x == 0) { __builtin_amdgcn_fence(__ATOMIC_ACQUIRE, "agent"); asm volatile("s_waitcnt vmcnt(0)" ::: "memory"); }
        __syncthreads();
        { ProbP3 P; P.nt = 4; P.ksw = 1 << 20; P.mid_kt = -1; P.G = F.G; P.c0 = bx; P.mode = 0; P.ws = F.ws; P.b_s = INP(11); eng::gemm_phase(ring, P, F.wave); }
        p2_elementwise(F, args, 1);
    } SEAM(2);
    REP(3) if (IN(3)) { if (rep_) xcd_barrier(bar);
        { ProbP3 P; P.nt = 4; P.ksw = 1 << 20; P.mid_kt = -1; P.G = F.G; P.c0 = bx; P.mode = 1; P.ws = F.ws; P.b_s = INP(11); eng::gemm_phase(ring, P, F.wave); }
        p4_scan(F);
    } SEAM(3);
    REP(5) if (IN(5)) { if (rep_) xcd_barrier(bar);
        for (int idx = bx; idx < 256; idx += F.G) { ProbO P; P.nt = 8; P.ksw = 4; P.mid_kt = -1; P.idx = idx; P.ws = F.ws; P.gn_m = INP(7); eng::gemm_phase(ring, P, F.wave); }
    } SEAM(5);
    REP(6) if (IN(6)) { if (rep_) xcd_barrier(bar); ProbG23 P; P.nt = 32; P.ksw = 16; P.mid_kt = 16; P.S.init(M, D, F.G, bx); P.ws = F.ws; eng::gemm_phase(ring, P, F.wave); } SEAM(6);
    REP(7) if (IN(7)) { if (rep_) xcd_barrier(bar); ProbG4 P; P.nt = 32; P.ksw = 1 << 20; P.mid_kt = -1; P.S.init(M, D, F.G, bx); P.ws = F.ws; eng::gemm_phase(ring, P, F.wave); } SEAM(7);
    REP(8) if (IN(8)) { if (rep_) xcd_barrier(bar); p8_router(F, args); } SEAM(8);
    LAS int* tstart = (LAS int*)(F.lds + XTR_OFF + 2048); LAS int* tcnt = tstart + 64;
    REP(9) if (IN(9)) { if (rep_) xcd_barrier(bar);
        moe_table(F, tstart, tcnt);
        const int nun = __builtin_amdgcn_readfirstlane(tstart[32]) * 4;
        { ProbMU P; P.nt = 32; P.ksw = 1 << 20; P.mid_kt = -1; P.G = F.G; P.c0 = bx; P.nun = nun; P.ws = F.ws; P.tstart = tstart; P.cnt = tcnt; eng::gemm_phase(ring, P, F.wave); }
    } SEAM(9);
    REP(10) if (IN(10)) { if (rep_) xcd_barrier(bar);
        moe_table(F, tstart, tcnt);
        ProbMD P; P.nt = 8; P.ksw = 1 << 20; P.mid_kt = -1; P.G = F.G; P.c0 = bx; P.ws = F.ws; P.tstart = tstart; P.cnt = tcnt; eng::gemm_phase(ring, P, F.wave);
    } SEAM(10);
    REP(11) if (IN(11)) { if (rep_) xcd_barrier(bar); p11_combine(F); } SEAM(11);
    REP(12) if (IN(12)) { if (rep_) xcd_barrier(bar); ProbPG P; P.nt = 32; P.ksw = 1 << 20; P.mid_kt = -1; P.S.init(M, D, F.G, bx); P.ws = F.ws; eng::gemm_phase(ring, P, F.wave); } SEAM(12);
    REP(13) if (IN(13)) { if (rep_) xcd_barrier(bar); p13_final(F, args); }
#undef IN
#undef SEAM
}

extern "C" void kernel_launch(void* const* d_in, const int* in_sizes, int n_in, void* d_out, int out_size, void* d_ws, size_t ws_size, hipStream_t stream) {
    static int grid = 0;
    if (grid == 0) {
        if (n_in != 27 || out_size != M * D || ws_size < WS_END) { fprintf(stderr, "kernel_launch: unexpected problem (n_in %d, out %d, ws %zu < %zu)\n", n_in, out_size, ws_size, (size_t)WS_END); grid = -1; return; }
        int dev = 0, cus = 0, per_cu = 0;
        if (hipGetDevice(&dev) != hipSuccess || hipDeviceGetAttribute(&cus, hipDeviceAttributeMultiprocessorCount, dev) != hipSuccess) { grid = -1; return; }
        if (hipFuncSetAttribute((const void*)mk_fwd, hipFuncAttributeMaxDynamicSharedMemorySize, LDS_BYTES) != hipSuccess) { fprintf(stderr, "kernel_launch: hipFuncSetAttribute failed\n"); grid = -1; return; }
        if (hipOccupancyMaxActiveBlocksPerMultiprocessor(&per_cu, (const void*)mk_fwd, NTHR, LDS_BYTES) != hipSuccess || per_cu < 1) fprintf(stderr, "kernel_launch: occupancy query reports %d\n", per_cu);
        (void)hipGetLastError();
        grid = cus;
    }
    if (grid < 0) return;
    (void)hipMemsetAsync((char*)d_ws + WS_CTL, 0, CTL_ZERO_BYTES, stream);
    Args a{};
    for (int i = 0; i < 27; ++i) a.in[i] = (const float*)d_in[i];
    a.out = (float*)d_out; a.ws = (unsigned char*)d_ws;
    if (N_LAUNCHES == 1) { a.ph_lo = 0; a.ph_hi = NPHASE; hipLaunchKernelGGL(mk_fwd, dim3(grid), dim3(NTHR), LDS_BYTES, stream, a); }
    else { for (int p = 0; p < NPHASE; ++p) { a.ph_lo = p; a.ph_hi = p + 1; hipLaunchKernelGGL(mk_fwd, dim3(grid), dim3(NTHR), LDS_BYTES, stream, a); } }
}
```

```cpp
#include <hip/hip_runtime.h>
#include <cstdio>
#include <cstdint>

#define LAS __attribute__((address_space(3)))
#define GAS __attribute__((address_space(1)))
typedef unsigned short bf16_t;
typedef short bf16x8 __attribute__((ext_vector_type(8)));
typedef float f32x4 __attribute__((ext_vector_type(4)));
typedef float f32x2 __attribute__((ext_vector_type(2)));
typedef unsigned u32x4 __attribute__((ext_vector_type(4)));
typedef unsigned u32x2 __attribute__((ext_vector_type(2)));
typedef GAS unsigned gu32;

#ifndef MK_N_LAUNCHES
#define MK_N_LAUNCHES 1
#endif
constexpr int NPHASE = 14;
constexpr int N_LAUNCHES = MK_N_LAUNCHES;
#ifndef PHASE_MASK
#define PHASE_MASK 0x3fff
#endif
#ifndef REPEAT_MASK
#define REPEAT_MASK 0
#endif

constexpr int D = 2048, BATCH = 4, SEQ = 4096, M = BATCH * SEQ;
constexpr int MW = 1024, MH = 4, DH = 256, GW = 1024, NEXP = 32, DE = 512, PLE = 256;
constexpr int INC = 10248, NG1 = 10240;
constexpr int LC = 256, NCH = SEQ / LC;
constexpr float EPS = 1e-6f;
constexpr int NWAVES = 8, NTHR = 512;

constexpr size_t MiB = 1u << 20;
constexpr size_t WS_CTL = 0, CTL_ZERO_BYTES = 1 * MiB;
constexpr size_t WS_R0 = 1 * MiB;
constexpr size_t WS_DUMP = WS_R0;
constexpr size_t WS_GATEPRE = WS_R0 + 65536;
constexpr size_t WS_GC = WS_GATEPRE + 524288;
constexpr size_t WS_NLOC = WS_GC + 4096;
constexpr size_t WS_DENPART = WS_NLOC + 262144;
constexpr size_t WS_DENINTER = WS_DENPART + 1048576;
constexpr size_t WS_R1 = WS_DENINTER + 262144;
constexpr size_t WS_R2 = WS_R1 + 65536;
constexpr size_t WS_LIST = 4 * MiB;
constexpr size_t WS_LISTW = 6 * MiB;
constexpr size_t WS_SSQ3 = 8 * MiB;
static_assert(WS_R2 + 65536 <= WS_LIST, "small map");
constexpr size_t WS_WB = 16 * MiB, WS_WOUT = 24 * MiB, WS_WPG = 32 * MiB, WS_WPU = 40 * MiB, WS_WSBLK = 41 * MiB;
constexpr size_t WS_WIN = 42 * MiB;
constexpr size_t WS_XB = 82 * MiB;
constexpr size_t WS_PB = 146 * MiB;
constexpr size_t WS_PLEV = 154 * MiB;
constexpr size_t WS_QRAW = 218 * MiB, WS_KRAW = 250 * MiB, WS_VGT = 282 * MiB, WS_VT = 314 * MiB, WS_SO = 346 * MiB, WS_GU = 378 * MiB;
constexpr size_t WS_GATES = 410 * MiB;
constexpr size_t WS_VNT = 538 * MiB;
constexpr size_t WS_HG = 570 * MiB;
constexpr size_t WS_END = 602 * MiB;
constexpr size_t WS_QS = 42 * MiB, WS_KS = 74 * MiB, WS_KST = 106 * MiB;
constexpr size_t WS_P = 218 * MiB, WS_KVT = 250 * MiB;
constexpr size_t WS_CPT = 74 * MiB;
constexpr size_t WS_HM = 106 * MiB;
constexpr size_t WS_MERGED = 250 * MiB;
constexpr size_t WS_MIX = 42 * MiB;
constexpr size_t WS_X1B = 250 * MiB;
constexpr size_t WS_GP = 42 * MiB;
constexpr size_t WS_W13 = 410 * MiB;
constexpr size_t WS_W2 = 346 * MiB;
constexpr size_t WS_H = 106 * MiB;
constexpr size_t WS_Y = 410 * MiB;
constexpr int CW_TMO = 0;
constexpr int CW_CNT = 1024;
constexpr int CW_BAR = 4096;
constexpr int CW_TICKP0 = 3840;
constexpr int W13_STATIC_ITEMS = 24 * 512;

constexpr int RING_BYTES = 131072;
constexpr int XTR_OFF = RING_BYTES;
constexpr int LDSCTL_OFF = RING_BYTES + 24576, MISC_OFF = LDSCTL_OFF + 320;
constexpr int LDS_BYTES = 163840;

#define RLX_AGENT __ATOMIC_RELAXED, __HIP_MEMORY_SCOPE_AGENT
#define LDS_WAIT() asm volatile("s_waitcnt lgkmcnt(0)" ::: "memory")
#define VM_WAIT() asm volatile("s_waitcnt vmcnt(0)" ::: "memory")
__device__ __forceinline__ unsigned f2bf(float f) { unsigned u = __builtin_bit_cast(unsigned, f); return (u + 0x7fffu + ((u >> 16) & 1u)) >> 16; }

typedef __bf16 bf16v2_t __attribute__((ext_vector_type(2)));
typedef float f32v2_t __attribute__((ext_vector_type(2)));
__device__ __forceinline__ unsigned cvt_pk_bf16(float lo, float hi) { const f32v2_t v = {lo, hi}; return __builtin_bit_cast(unsigned, __builtin_convertvector(v, bf16v2_t)); }
__device__ __forceinline__ unsigned pk2(float lo, float hi) { return cvt_pk_bf16(lo, hi); }
__device__ __forceinline__ float bflo(unsigned w) { return __uint_as_float(w << 16); }
__device__ __forceinline__ float bfhi(unsigned w) { return __uint_as_float(w & 0xffff0000u); }
__device__ __forceinline__ float bf2f(bf16_t b) { return __uint_as_float((unsigned)b << 16); }
__device__ __forceinline__ float fsigmoid(float x) { return __builtin_amdgcn_rcpf(1.0f + __expf(-x)); }
__device__ __forceinline__ float fgelu_tanh(float x) { const float z = 1.5957691216f * (x + 0.044715f * x * x * x); return x * __builtin_amdgcn_rcpf(1.0f + __expf(-z)); }
__device__ __forceinline__ float fsilu(float x) { return x * __builtin_amdgcn_rcpf(1.0f + __expf(-x)); }
__device__ __forceinline__ float wave_sum(float v) {
#pragma unroll
    for (int o = 1; o < 64; o <<= 1) v += __shfl_xor(v, o);
    return v;
}


__device__ __forceinline__ __amdgpu_buffer_rsrc_t ws_rsrc(const unsigned char* ws) { return __builtin_amdgcn_make_buffer_rsrc((void*)ws, 0, 0xffffffffu, 0x00020000); }
__device__ __forceinline__ void wt16(const unsigned char* ws, const void* p, u32x4 v) { __builtin_amdgcn_raw_buffer_store_b128(v, ws_rsrc(ws), (unsigned)((const unsigned char*)p - ws), 0, 16); }
__device__ __forceinline__ void wt16f(const unsigned char* ws, const void* p, f32x4 v) { __builtin_amdgcn_raw_buffer_store_b128(__builtin_bit_cast(u32x4, v), ws_rsrc(ws), (unsigned)((const unsigned char*)p - ws), 0, 16); }
__device__ __forceinline__ void wt8(const unsigned char* ws, const void* p, u32x2 v) { __builtin_amdgcn_raw_buffer_store_b64(v, ws_rsrc(ws), (unsigned)((const unsigned char*)p - ws), 0, 16); }
__device__ __forceinline__ void wt4(const unsigned char* ws, const void* p, unsigned v) { __builtin_amdgcn_raw_buffer_store_b32(v, ws_rsrc(ws), (unsigned)((const unsigned char*)p - ws), 0, 16); }
__device__ __forceinline__ void wt4f(const unsigned char* ws, const void* p, float v) { __builtin_amdgcn_raw_buffer_store_b32(__builtin_bit_cast(unsigned, v), ws_rsrc(ws), (unsigned)((const unsigned char*)p - ws), 0, 16); }

#define XB_TMO      128
#define XB_XCNT(j)  (256  + 64 * (j))
#define XB_XSUB(j)  (1280 + 64 * (j))
#define XB_XGEN(j)  (2304 + 64 * (j))
#define XB_TOP      3328
#define XB_TOPGEN   3392
#define XCD_BAR_WORDS 3456
#define XB_SPIN_CAP (1u << 18)
__device__ __forceinline__ unsigned xb_ld(unsigned* p)              { return __hip_atomic_load(p, __ATOMIC_RELAXED, __HIP_MEMORY_SCOPE_AGENT); }
__device__ __forceinline__ unsigned xb_add(unsigned* p, unsigned v) { return __hip_atomic_fetch_add(p, v, __ATOMIC_RELAXED, __HIP_MEMORY_SCOPE_AGENT); }
__device__ __forceinline__ unsigned xb_xcc_id() { return (unsigned)__builtin_amdgcn_s_getreg((3 << 11) | 20) & 0xFu; }
#define XB_SPIN(cond, bar) do { unsigned _sp = 0; while (cond) { __builtin_amdgcn_s_sleep(1); \
    if ((++_sp & 255u) == 0u) { if (xb_ld(&(bar)[XB_TMO])) break; if (_sp > XB_SPIN_CAP) { atomicAdd(&(bar)[XB_TMO], 1u); break; } } } } while (0)
struct XcdBarrier { unsigned* bar; unsigned x; volatile LAS unsigned* st; };
__device__ __forceinline__ XcdBarrier xcd_barrier_post(unsigned* bar, volatile LAS unsigned* st) {
    XcdBarrier b; b.bar = bar; b.x = xb_xcc_id(); b.st = st;
    if (threadIdx.x == 0) (void)xb_add(&bar[XB_XCNT(b.x)], 1u);
    return b;
}
__device__ __forceinline__ void xcd_barrier_complete(unsigned* bar, unsigned x, unsigned& nloc, unsigned& nx) {
    const unsigned G = gridDim.x * gridDim.y * gridDim.z;
    unsigned sum, cnt, mine, sp = 0u;
    for (;;) {
        sum = 0u; cnt = 0u; mine = 0u;
#pragma unroll
        for (unsigned j = 0; j < 16; ++j) { const unsigned c = xb_ld(&bar[XB_XCNT(j)]); sum += c; cnt += (c > 0u) ? 1u : 0u; mine = (j == x) ? c : mine; }
        if (sum == G) break;
        __builtin_amdgcn_s_sleep(1);
        if ((++sp & 255u) == 0u) { if (xb_ld(&bar[XB_TMO])) break; if (sp > XB_SPIN_CAP) { atomicAdd(&bar[XB_TMO], 1u); break; } }
    }
    nloc = mine > 0u ? mine : 1u; nx = cnt > 0u ? cnt : 1u;
}
__device__ __forceinline__ void xcd_barrier(const XcdBarrier& b) {
    asm volatile("s_waitcnt vmcnt(0)" ::: "memory");
    __syncthreads();
    if (threadIdx.x == 0) {
        unsigned* bar = b.bar;
        __builtin_amdgcn_s_waitcnt(0);
        asm volatile("buffer_inv sc1" ::: "memory");
        unsigned nloc = b.st[0], nx = b.st[1]; const unsigned k = b.st[2]; b.st[2] = k + 1u;
        if (nloc == 0u) { xcd_barrier_complete(bar, b.x, nloc, nx); b.st[0] = nloc; b.st[1] = nx; }
        const unsigned old = xb_add(&bar[XB_XSUB(b.x)], 1u);
        const unsigned gen = old / nloc;
        if (old + 1u == (gen + 1u) * nloc) {
            const unsigned og = xb_add(&bar[XB_TOP], 1u);
            const unsigned tg = og / nx;
            if (og + 1u == (tg + 1u) * nx) xb_add(&bar[XB_TOPGEN], 1u);
        }
        XB_SPIN(xb_ld(&bar[XB_TOPGEN]) == k, bar);
        asm volatile("s_waitcnt vmcnt(0)" ::: "memory");
    }
    __syncthreads();
}

namespace eng {
__device__ __forceinline__ int lane_id2() { int l; asm volatile("v_mbcnt_lo_u32_b32 %0, -1, 0\n\tv_mbcnt_hi_u32_b32 %0, -1, %0" : "=v"(l)); return l; }
constexpr int BM = 256, BK = 64, HALF = 128, HTB = HALF * BK * 2, NXCD = 8, WGM = 8;
__host__ __device__ __forceinline__ int lds_byte(int r, int c) { const int st = (r >> 4) * 2 + (c >> 5), rr = r & 15, cc = c & 31, ob = rr * 64 + cc * 2; return st * 1024 + (ob ^ (((ob >> 9) & 1) << 5)); }
__host__ __device__ __forceinline__ void stage_rc(int b, int& R, int& C) { const int st = b / 1024, sb = b % 1024, swz = sb ^ (((sb >> 9) & 1) << 5); R = (st >> 1) * 16 + swz / 64; C = (st & 1) * 32 + (swz % 64) / 2; }
__host__ __device__ __forceinline__ int perm32(int rho) { const int n = rho >> 4, i = rho & 15; return 8 * (i >> 2) + 4 * n + (i & 3); }

struct Unit { int pm, pn, ex; };
struct USrc { const char* a0; const char* a1; const char* b0; const char* b1; };

struct StaticOrder {
    int nM, nN, nwg, G, c;
    __device__ void init(int Mr, int Nc, int G_, int c_) { nM = Mr / BM; nN = Nc / BM; nwg = nM * nN; G = G_; c = c_; }
    __device__ bool next(int i, Unit& u) const {
        const long L = (long)i * G + c; if (L >= nwg) return false;
        int wgid = (int)L; { const int q = nwg / NXCD, r = nwg % NXCD, xcd = wgid % NXCD, off = wgid / NXCD; wgid = (xcd < r ? xcd * (q + 1) : r * (q + 1) + (xcd - r) * q) + off; }
        const int nig = WGM * nN, gid = wgid / nig, fm = gid * WGM, gsz = (nM - fm) < WGM ? (nM - fm) : WGM;
        u.pm = fm + ((wgid % nig) % gsz); u.pn = (wgid % nig) / gsz; u.ex = 0; return true;
    }
};

template <class Prob>
__device__ __forceinline__ void gemm_phase(LAS unsigned char* lds, const Prob& P, const int wave_id) {
    constexpr int NSEG = Prob::NSEG;
    constexpr int AUXA = Prob::NT_A ? 2 : 0, AUXB = Prob::NT_B ? 2 : 0;
    int lane; asm volatile("v_mbcnt_lo_u32_b32 %0, -1, 0\n\tv_mbcnt_hi_u32_b32 %0, -1, %0" : "=v"(lane));
    const int wid = wave_id, tid = wid * 64 + lane, wr = wid >> 2, wc = wid & 3, fr = lane & 15, fq = lane >> 4;
    int nt = P.nt; asm volatile("" : "+s"(nt));
    const int ksw = P.ksw;
    unsigned Rg0, Rbg0, Cg0;
    { int R, C; stage_rc(tid * 16, R, C); Rg0 = (unsigned)R; Cg0 = (unsigned)C * 2u; asm volatile("" : "+v"(Rg0), "+v"(Cg0));
      if (Prob::PERM) { Rbg0 = (unsigned)((R & ~31) + perm32(R & 31)); asm volatile("" : "+v"(Rbg0)); } else Rbg0 = Rg0; }
    const unsigned ldsw = (unsigned)wid * 1024u;
    const int aoff = lds_byte(wr * 64 + fr, fq * 8), boff = lds_byte(wc * 32 + fr, fq * 8);
    unsigned ag[2][2], agn[2][2];
#define EG_SA(b, h) (((b) * 2 + (h)) * HTB)
#define EG_SB(b, h) ((4 + (b) * 2 + (h)) * HTB)
#define EG_STAGE_B(bufoff, p0, p1, kt, h) do { const bool _sg = (NSEG == 2) && ((kt) >= ksw); const unsigned _ld = _sg ? Prob::ldb1 : Prob::ldb0; \
        const char* _p = _sg ? (p1) + (size_t)((kt) - ksw) * 128 + (size_t)(h) * 128 * Prob::ldb1 : (p0) + (size_t)(kt) * 128 + (size_t)(h) * 128 * Prob::ldb0; \
        const unsigned _vo = Rbg0 * _ld + Cg0; \
        __builtin_amdgcn_global_load_lds((const unsigned*)(_p + _vo), (LAS unsigned*)(lds + (bufoff) + ldsw), 16, 0, AUXB); \
        __builtin_amdgcn_global_load_lds((const unsigned*)(_p + (size_t)64 * _ld + _vo), (LAS unsigned*)(lds + (bufoff) + ldsw + 8192), 16, 0, AUXB); } while (0)
#define EG_STAGE_A(bufoff, p0, p1, kt, h) do { if constexpr (Prob::GATHER) { const char* _p = (p0) + (size_t)(kt) * 128; _Pragma("unroll") for (int _i = 0; _i < 2; ++_i) \
        __builtin_amdgcn_global_load_lds((const unsigned*)(_p + (use_n ? agn[h][_i] : ag[h][_i])), (LAS unsigned*)(lds + (bufoff) + ldsw + _i * 8192), 16, 0, AUXA); } \
    else { const bool _sg = (NSEG == 2) && ((kt) >= ksw); const unsigned _ld = _sg ? Prob::lda1 : Prob::lda0; \
        const char* _p = _sg ? (p1) + (size_t)((kt) - ksw) * 128 + (size_t)(h) * 128 * Prob::lda1 : (p0) + (size_t)(kt) * 128 + (size_t)(h) * 128 * Prob::lda0; \
        const unsigned _vo = Rg0 * _ld + Cg0; \
        __builtin_amdgcn_global_load_lds((const unsigned*)(_p + _vo), (LAS unsigned*)(lds + (bufoff) + ldsw), 16, 0, AUXA); \
        __builtin_amdgcn_global_load_lds((const unsigned*)(_p + (size_t)64 * _ld + _vo), (LAS unsigned*)(lds + (bufoff) + ldsw + 8192), 16, 0, AUXA); } } while (0)
#define EG_LDA(dst, b, h) do { _Pragma("unroll") for (int m = 0; m < 4; ++m) _Pragma("unroll") for (int k = 0; k < 2; ++k) dst[m][k] = *(const LAS bf16x8*)(lds + EG_SA(b, h) + aoff + m * 2048 + k * 1024); } while (0)
#define EG_LDB(dst, b, h) do { _Pragma("unroll") for (int n = 0; n < 2; ++n) _Pragma("unroll") for (int k = 0; k < 2; ++k) dst[n][k] = *(const LAS bf16x8*)(lds + EG_SB(b, h) + boff + n * 2048 + k * 1024); } while (0)
#define EG_MMA(ai, bj, At, Bt) do { __builtin_amdgcn_s_setprio(1); _Pragma("unroll") for (int m = 0; m < 4; ++m) _Pragma("unroll") for (int n = 0; n < 2; ++n) _Pragma("unroll") for (int k = 0; k < 2; ++k) \
        acc[ai][bj][m][n] = __builtin_amdgcn_mfma_f32_16x16x32_bf16(Bt[n][k], At[m][k], acc[ai][bj][m][n], 0, 0, 0); __builtin_amdgcn_s_setprio(0); } while (0)
#define EG_WAIT_V(n) asm volatile("s_waitcnt vmcnt(" #n ")" ::: "memory")
#define EG_WAIT_V8R(relax) do { if (relax) asm volatile("s_waitcnt vmcnt(%0)" :: "n"(8 + Prob::EPI_VM) : "memory"); else EG_WAIT_V(8); } while (0)
#define EG_WAIT_L(n) asm volatile("s_waitcnt lgkmcnt(" #n ")" ::: "memory")
#define EG_BAR __builtin_amdgcn_s_barrier()
#define EG_SCHED __builtin_amdgcn_sched_barrier(0)
    Unit cur, nxt; int ui = 0;
    if (!P.next(0, cur)) return;
    USrc sc, sn; P.src(cur, sc);
    if constexpr (Prob::GATHER) {
#pragma unroll
        for (int h = 0; h < 2; ++h)
#pragma unroll
            for (int i = 0; i < 2; ++i) { ag[h][i] = P.arow(cur, h * 128 + i * 64 + (int)Rg0) + Cg0; asm volatile("" : "+v"(ag[h][i])); }
    }
    u32x2 keep[2][4][2];
#pragma unroll
    for (int a = 0; a < 2; ++a)
#pragma unroll
        for (int m = 0; m < 4; ++m) { keep[a][m][0] = (u32x2){0u, 0u}; keep[a][m][1] = (u32x2){0u, 0u}; }
    f32x4 acc[2][2][4][2];
#pragma unroll
    for (int a = 0; a < 2; ++a)
#pragma unroll
        for (int b = 0; b < 2; ++b)
#pragma unroll
            for (int m = 0; m < 4; ++m)
#pragma unroll
                for (int n = 0; n < 2; ++n) acc[a][b][m][n] = (f32x4){0.f, 0.f, 0.f, 0.f};
    bf16x8 At[4][2], B0[2][2], B1[2][2];
    bool use_n = false;
    EG_STAGE_B(EG_SB(0, 0), sc.b0, sc.b1, 0, 0); EG_STAGE_B(EG_SB(0, 1), sc.b0, sc.b1, 0, 1); EG_STAGE_A(EG_SA(0, 0), sc.a0, sc.a1, 0, 0); EG_STAGE_A(EG_SA(0, 1), sc.a0, sc.a1, 0, 1);
    if (wr == 1) EG_BAR;
    EG_WAIT_V(2); EG_BAR;
    EG_STAGE_B(EG_SB(1, 0), sc.b0, sc.b1, 1, 0); EG_STAGE_A(EG_SA(1, 0), sc.a0, sc.a1, 1, 0); EG_STAGE_B(EG_SB(1, 1), sc.b0, sc.b1, 1, 1);
    EG_WAIT_V(6); EG_BAR;
    for (;;) {
        const bool has_next = P.next(ui + 1, nxt);
        if (has_next) P.src(nxt, sn); else sn = sc;
        for (int t = 0; t < nt; t += 2) {
            const bool last = (t == nt - 2);
            const char* qa0 = last ? sn.a0 : sc.a0; const char* qa1 = last ? sn.a1 : sc.a1; const char* qb0 = last ? sn.b0 : sc.b0; const char* qb1 = last ? sn.b1 : sc.b1;
            const int k2 = last ? 0 : t + 2, k3 = k2 + 1;
            if constexpr (Prob::HAS_MID) { if (t == P.mid_kt) { const int l2 = lane_id2(); P.mid(acc, keep, cur, wr, wc, l2 & 15, l2 >> 4); } }
            const bool relax = (Prob::EPI_VM > 0) && (t == 0) && (ui > 0);
            EG_LDB(B0, 0, 0); EG_LDB(B1, 0, 1); EG_SCHED; EG_LDA(At, 0, 0); if (!relax) EG_STAGE_A(EG_SA(1, 1), sc.a0, sc.a1, t + 1, 1);
            EG_WAIT_V8R(relax); EG_WAIT_L(0); EG_BAR; EG_MMA(0, 0, At, B0); EG_MMA(0, 1, At, B1); EG_BAR; EG_SCHED;
            if constexpr (Prob::GATHER) {
                if (last && has_next) {
#pragma unroll
                    for (int h = 0; h < 2; ++h)
#pragma unroll
                        for (int i = 0; i < 2; ++i) { agn[h][i] = P.arow(nxt, h * 128 + i * 64 + (int)Rg0) + Cg0; asm volatile("" : "+v"(agn[h][i])); }
                    use_n = true; }
            }
            EG_LDA(At, 0, 1); EG_STAGE_B(EG_SB(0, 0), qb0, qb1, k2, 0); EG_STAGE_B(EG_SB(0, 1), qb0, qb1, k2, 1); EG_STAGE_A(EG_SA(0, 0), qa0, qa1, k2, 0);
            EG_WAIT_V8R(relax); EG_WAIT_L(0); EG_BAR; EG_MMA(1, 0, At, B0); EG_MMA(1, 1, At, B1); EG_BAR; EG_SCHED;
            EG_LDB(B0, 1, 0); EG_LDB(B1, 1, 1); EG_SCHED; EG_LDA(At, 1, 0); EG_STAGE_A(EG_SA(0, 1), qa0, qa1, k2, 1);
            EG_WAIT_V8R(relax); EG_WAIT_L(0); EG_BAR; EG_MMA(0, 0, At, B0); EG_MMA(0, 1, At, B1); EG_BAR; EG_SCHED;
            EG_LDA(At, 1, 1); EG_STAGE_B(EG_SB(1, 0), qb0, qb1, k3, 0); EG_STAGE_B(EG_SB(1, 1), qb0, qb1, k3, 1); EG_STAGE_A(EG_SA(1, 0), qa0, qa1, k3, 0);
            EG_WAIT_V(8); EG_WAIT_L(0); EG_BAR; EG_MMA(1, 0, At, B0); EG_MMA(1, 1, At, B1); EG_BAR; EG_SCHED;
        }
        if constexpr (Prob::EPI_VM > 0) { if (has_next) EG_STAGE_A(EG_SA(1, 1), sn.a0, sn.a1, 1, 1); }
        if constexpr (Prob::ALIGN) { if (wr == 0) EG_BAR; }
        if constexpr (!Prob::AFTER_DRAIN) { const int l2 = lane_id2(); if constexpr (Prob::HAS_MID) P.epi_keep(acc, keep, cur, wr, wc, l2 & 15, l2 >> 4); else P.epi(acc, cur, wr, wc, l2 & 15, l2 >> 4); }
        if (!has_next) break;
#pragma unroll
        for (int a = 0; a < 2; ++a)
#pragma unroll
            for (int b = 0; b < 2; ++b)
#pragma unroll
                for (int m = 0; m < 4; ++m)
#pragma unroll
                    for (int n = 0; n < 2; ++n) acc[a][b][m][n] = (f32x4){0.f, 0.f, 0.f, 0.f};
        cur = nxt; sc = sn; ++ui;
        if constexpr (Prob::GATHER) { ag[0][0] = agn[0][0]; ag[0][1] = agn[0][1]; ag[1][0] = agn[1][0]; ag[1][1] = agn[1][1]; use_n = false; }
        if constexpr (Prob::ALIGN) { if (wr == 1) EG_BAR; }
    }
    EG_WAIT_V(0);
    if constexpr (!Prob::ALIGN) { if (wr == 0) EG_BAR; }
    EG_BAR;
    if constexpr (Prob::AFTER_DRAIN) { const int l2 = lane_id2(); P.fused(acc, cur, wr, wc, l2 & 15, l2 >> 4, lds, wid, l2); }
#undef EG_SA
#undef EG_SB
#undef EG_STAGE_A
#undef EG_STAGE_B
#undef EG_LDA
#undef EG_LDB
#undef EG_MMA
#undef EG_WAIT_V
#undef EG_WAIT_V8R
#undef EG_WAIT_L
#undef EG_BAR
#undef EG_SCHED
}
}
using eng::Unit; using eng::USrc;
typedef f32x4 Acc[2][2][4][2];

struct Frame {
    LAS unsigned char* lds;
    volatile LAS unsigned* MISC;
    gu32* ctl;
    int wave, vcu, G;
    float* out; unsigned char* ws;
};
#define WSP(T, off) ((T*)(F.ws + (off)))
__device__ __forceinline__ int lane_id() { int l; asm volatile("v_mbcnt_lo_u32_b32 %0, -1, 0\n\tv_mbcnt_hi_u32_b32 %0, -1, %0" : "=v"(l)); return l; }
#define E0(j) (512 * ((j) >> 1) + 8 * lane + 4 * ((j) & 1))
#define DECL_TID const int lane = lane_id(), tid = F.wave * 64 + lane; (void)tid; (void)lane;
struct Args { const float* in[27]; float* out; unsigned char* ws; int ph_lo, ph_hi; };
#define INP(i) (args.in[i])

__device__ __forceinline__ u32x4 pack8(const f32x4 v0, const f32x4 v1) { u32x4 w; w.x = cvt_pk_bf16(v0[0], v0[1]); w.y = cvt_pk_bf16(v0[2], v0[3]); w.z = cvt_pk_bf16(v1[0], v1[1]); w.w = cvt_pk_bf16(v1[2], v1[3]); return w; }
template <int ACT> __device__ __forceinline__ f32x4 act4(f32x4 v) {
    if (ACT == 1) { v[0] = fsigmoid(v[0]); v[1] = fsigmoid(v[1]); v[2] = fsigmoid(v[2]); v[3] = fsigmoid(v[3]); }
    if (ACT == 2) { v[0] = fgelu_tanh(v[0]); v[1] = fgelu_tanh(v[1]); v[2] = fgelu_tanh(v[2]); v[3] = fgelu_tanh(v[3]); }
    return v;
}

constexpr int TSCR_BYTES = 64 * 65 * 4;
__device__ __forceinline__ void transpose_item(const unsigned char* ws_base_, const float* slp, size_t srcld, const float* ksc, int k0, bf16_t* dst, size_t dstld, LAS float* scr, int lane) {
    const int kr = lane >> 4, ns = (lane & 15) * 4;
    f32x4 v[16];
#pragma unroll
    for (int i = 0; i < 16; ++i) v[i] = __builtin_nontemporal_load((const GAS f32x4*)(slp + (size_t)(k0 + 4 * i + kr) * srcld));
#pragma unroll
    for (int i = 0; i < 16; ++i) { const int kk = 4 * i + kr; f32x4 w = v[i]; if (ksc) w = w * ksc[k0 + kk];
        LAS float* p = scr + kk * 65 + ns; p[0] = w[0]; p[1] = w[1]; p[2] = w[2]; p[3] = w[3]; }
    LDS_WAIT(); asm volatile("" ::: "memory");
    const int c = lane & 7, nl = lane >> 3;
#pragma unroll
    for (int p = 0; p < 8; ++p) { const int n = 8 * p + nl; const LAS float* q = scr + (8 * c) * 65 + n;
        u32x4 o; o.x = pk2(q[0 * 65], q[1 * 65]); o.y = pk2(q[2 * 65], q[3 * 65]); o.z = pk2(q[4 * 65], q[5 * 65]); o.w = pk2(q[6 * 65], q[7 * 65]);
        wt16(ws_base_, dst + (size_t)n * dstld + 8 * c, o); }
    LDS_WAIT(); asm volatile("" ::: "memory");
}

__device__ __forceinline__ void p0_prologue(Frame& F, const Args& args) {
    const unsigned char* ws_base_ = F.ws;
    LAS float* scr = (LAS float*)(F.lds + F.wave * TSCR_BYTES);
    DECL_TID; const int gw = F.vcu * NWAVES + F.wave, NGW = F.G * NWAVES;
    const float* w_in = INP(3); const float* g_mix = INP(2);
    constexpr int I_IN = 32 * 160, I_BM = 16 * 32, I_BG = 16 * 32, I_OUT = 32 * 32, I_PG = 32 * 32, I_PU = 4 * 32;
    static_assert((I_IN + I_PU) % 8 == 0, "batches of 8");
    constexpr int NITEMS = I_IN + I_PU;
    const int ns4 = (lane & 15) * 4;
    const int gt = F.vcu * NTHR + tid, NGT = F.G * NTHR;
    { const float* w_s = INP(10); bf16_t* wsb = WSP(bf16_t, WS_WSBLK);
      for (int i2 = gt; i2 < 4 * 256 * 256 / 2; i2 += NGT) { const int idx = i2 * 2, gp = idx >> 16, r = (idx >> 8) & 255, c = idx & 255, gi = r >> 7, t = r & 127, gj = c >> 7, s = c & 127;
          const float v0 = (gi == gj && s <= t) ? w_s[(size_t)(2 * gp + gi) * 16384 + t * 128 + s] : 0.f, v1 = (gi == gj && s + 1 <= t) ? w_s[(size_t)(2 * gp + gi) * 16384 + t * 128 + s + 1] : 0.f;
          wt4(ws_base_, wsb + idx, pk2(v0, v1)); } }
    { const float* p = INP(1); bf16_t* pb = WSP(bf16_t, WS_PB);
      for (int idx = gt; idx < M * PLE / 8; idx += NGT) { const f32x4 a = __builtin_nontemporal_load((const GAS f32x4*)(p + (size_t)idx * 8)), b = __builtin_nontemporal_load((const GAS f32x4*)(p + (size_t)idx * 8 + 4));
          u32x4 o; o.x = pk2(a[0], a[1]); o.y = pk2(a[2], a[3]); o.z = pk2(b[0], b[1]); o.w = pk2(b[2], b[3]); wt16(ws_base_, pb + (size_t)idx * 8, o); } }
    __syncthreads();
    LAS float* g8 = (LAS float*)F.lds;
    for (int idx = tid; idx < 8 * D; idx += NTHR) { const int k = idx >> 3, j = idx & 7; g8[j * D + k] = w_in[(size_t)k * INC + 4096 + j] * g_mix[k]; }
    __syncthreads();
    { const float* x = INP(0); const float* b_gate = INP(6); bf16_t* xb = WSP(bf16_t, WS_XB); float* gp = WSP(float, WS_GATEPRE);
      for (int m = gw; m < M; m += NGW) {
          const float* xrow = x + (size_t)m * D;
          f32x4 v[8]; float ss = 0.f;
#pragma unroll
          for (int j = 0; j < 8; ++j) { v[j] = __builtin_nontemporal_load((const GAS f32x4*)(xrow + E0(j)));     ss += (v[j][0] * v[j][0] + v[j][1] * v[j][1]) + (v[j][2] * v[j][2] + v[j][3] * v[j][3]); }
          float mine = 0.f;
#pragma unroll 1
          for (int g = 0; g < 8; ++g) { float a = 0.f;
#pragma unroll
              for (int j = 0; j < 8; ++j) { const f32x4 w = *(const LAS f32x4*)(g8 + g * D + E0(j)); a += (v[j][0] * w[0] + v[j][1] * w[1]) + (v[j][2] * w[2] + v[j][3] * w[3]); }
              a = wave_sum(a); mine = (lane == g) ? a : mine; }
          ss = wave_sum(ss);
          const float r = 1.0f / sqrtf(ss * (1.0f / D) + EPS);
#pragma unroll
          for (int p = 0; p < 4; ++p) wt16(ws_base_, xb + (size_t)m * D + 512 * p + 8 * lane, pack8(v[2 * p] * r, v[2 * p + 1] * r));
          if (lane < 8) wt4f(ws_base_, gp + (size_t)m * 8 + lane, r * mine + b_gate[lane]);
      } }
    for (;;) {
        if (tid == 0) F.MISC[23] = __hip_atomic_fetch_add((unsigned*)(F.ctl + CW_TICKP0), 1u, RLX_AGENT);
        __syncthreads();
        const int bt = (int)F.MISC[23];
        __syncthreads();
        if (bt >= NITEMS / 8) break;
        int r = bt * 8 + F.wave;
        if (r < I_IN) { const int kb = r / 160, nb = r % 160, d0 = nb * 64, sc0 = d0 < 4096 ? d0 : d0 + 8;
            transpose_item(F.ws, w_in + sc0 + ns4, INC, g_mix, kb * 64, WSP(bf16_t, WS_WIN) + (size_t)d0 * D + kb * 64, D, scr, lane); }
        else { r -= I_IN; const int kb = r / 32, nb = r % 32;
            transpose_item(F.ws, INP(24) + nb * 64 + ns4, D, nullptr, kb * 64, WSP(bf16_t, WS_WPU) + (size_t)(nb * 64) * PLE + kb * 64, PLE, scr, lane); }
    }
    __syncthreads();
}

struct ProbG1 {
    static constexpr bool NT_A = false, NT_B = false; static constexpr int EPI_VM = 8;  static constexpr bool PERM = true, AFTER_DRAIN = false, ALIGN = true, HAS_MID = false, GATHER = false; static constexpr int NSEG = 1; static constexpr unsigned lda0 = 4096u, lda1 = 4096u, ldb0 = 4096u, ldb1 = 4096u;
    int nt, ksw, mid_kt; eng::StaticOrder S; unsigned char* ws;
    __device__ __forceinline__ bool next(int i, Unit& u) const { return S.next(i, u); }
    __device__ __forceinline__ void src(const Unit& u, USrc& s) const {
        const int cb = u.pn >> 2; const bool sw = (cb == 2 || cb == 5);
        const char* xa = (const char*)(ws + WS_XB) + (size_t)u.pm * 256 * 4096; const char* wa = (const char*)(ws + WS_WIN) + (size_t)u.pn * 256 * 4096;
        s.a0 = sw ? wa : xa; s.b0 = sw ? xa : wa; s.a1 = s.a0; s.b1 = s.b0;
    }
    template <int ACT> __device__ __forceinline__ void epi_nat(const Acc& acc, const Unit& u, int wr, int wc, int fr, int fq, bf16_t* dst, int ldd, int colt) const {
        const unsigned char* ws_base_ = ws;
        const int row0 = u.pm * 256 + wr * 64 + fr, col0 = colt + wc * 32 + 8 * fq;
#pragma unroll
        for (int ai = 0; ai < 2; ++ai)
#pragma unroll
            for (int m = 0; m < 4; ++m) { const int row = row0 + ai * 128 + m * 16; bf16_t* rowp = dst + (size_t)row * ldd + col0;
#pragma unroll
                for (int bj = 0; bj < 2; ++bj) { const f32x4 v0 = act4<ACT>(acc[ai][bj][m][0]), v1 = act4<ACT>(acc[ai][bj][m][1]);
                    wt16(ws_base_, rowp + bj * 128, pack8(v0, v1)); } }
    }
    template <int ACT, bool CHUNKED> __device__ __forceinline__ void epi_swp(const Acc& acc, const Unit& u, int wr, int wc, int fr, int fq, bf16_t* dst) const {
        const unsigned char* ws_base_ = ws;
        const int ch0 = (u.pn & 3) * 256 + wr * 64 + fr, tk0 = u.pm * 256 + wc * 32 + 8 * fq;
#pragma unroll
        for (int ai = 0; ai < 2; ++ai)
#pragma unroll
            for (int m = 0; m < 4; ++m) { bf16_t* rowp = CHUNKED ? dst + ((size_t)(((u.pm >> 4) * MH + (u.pn & 3)) * NCH + (u.pm & 15)) * 256 + (wr * 64 + fr + ai * 128 + m * 16)) * 256 + wc * 32 + 8 * fq
                                                                       : dst + (size_t)(ch0 + ai * 128 + m * 16) * M + tk0;
#pragma unroll
                for (int bj = 0; bj < 2; ++bj) { const f32x4 v0 = act4<ACT>(acc[ai][bj][m][0]), v1 = act4<ACT>(acc[ai][bj][m][1]);
                    wt16(ws_base_, rowp + bj * 128, pack8(v0, v1)); } }
    }
    static __device__ __forceinline__ unsigned pack4u8(const f32x4 v, const unsigned lo) {
        const unsigned q0 = max((unsigned)fmaf(v[0], 255.f, 0.5f), lo), q1 = max((unsigned)fmaf(v[1], 255.f, 0.5f), lo), q2 = max((unsigned)fmaf(v[2], 255.f, 0.5f), lo), q3 = max((unsigned)fmaf(v[3], 255.f, 0.5f), lo);
        return q0 | (q1 << 8) | (q2 << 16) | (q3 << 24); }
    __device__ __forceinline__ void epi_gate8(const Acc& acc, const Unit& u, int wr, int wc, int fr, int fq) const {
        const unsigned char* ws_base_ = ws; unsigned char* gt = ws + WS_GATES + (size_t)(u.pm * 16 + (u.pn - 24)) * 65536;
        const unsigned lo = u.pn >= 32 ? 1u : 0u; const bool odd = (fq & 1) != 0;
        const int lofs = (odd ? 512 : 0) + fr * 32 + (fq & ~1) * 8;
#pragma unroll
        for (int ai = 0; ai < 2; ++ai)
#pragma unroll
            for (int m = 0; m < 4; ++m) { const int q = ((ai * 2 + wr) * 4 + m) * 4 + wc;
                u32x2 w0, w1;
                w0.x = pack4u8(act4<1>(acc[ai][0][m][0]), lo); w0.y = pack4u8(act4<1>(acc[ai][0][m][1]), lo);
                w1.x = pack4u8(act4<1>(acc[ai][1][m][0]), lo); w1.y = pack4u8(act4<1>(acc[ai][1][m][1]), lo);
                const unsigned sx = odd ? w0.x : w1.x, sy = odd ? w0.y : w1.y;
                const unsigned px = (unsigned)__shfl_xor((int)sx, 16), py = (unsigned)__shfl_xor((int)sy, 16);
                u32x4 o; if (!odd) { o.x = w0.x; o.y = w0.y; o.z = px; o.w = py; } else { o.x = px; o.y = py; o.z = w1.x; o.w = w1.y; }
                wt16(ws_base_, gt + q * 1024 + lofs, o); }
    }
    __device__ __forceinline__ void epi(const Acc& acc, const Unit& u, int wr, int wc, int fr, int fq) const { asm volatile("" : "+v"(fr), "+v"(fq)); const unsigned char* ws_base_ = ws; (void)ws_base_;
        const int cb = u.pn >> 2, colt = (u.pn & 3) * 256;
        if (cb == 0) epi_nat<0>(acc, u, wr, wc, fr, fq, (bf16_t*)(ws + WS_QRAW), MW, colt);
        else if (cb == 1) epi_nat<0>(acc, u, wr, wc, fr, fq, (bf16_t*)(ws + WS_KRAW), MW, colt);
        else if (cb == 2) epi_swp<0, true>(acc, u, wr, wc, fr, fq, (bf16_t*)(ws + WS_VT));
        else if (cb == 3) epi_nat<1>(acc, u, wr, wc, fr, fq, (bf16_t*)(ws + WS_SO), MW, colt);
        else if (cb == 4) epi_nat<2>(acc, u, wr, wc, fr, fq, (bf16_t*)(ws + WS_GU), GW, colt);
        else if (cb == 5) epi_swp<2, false>(acc, u, wr, wc, fr, fq, (bf16_t*)(ws + WS_VGT));
        else epi_gate8(acc, u, wr, wc, fr, fq);
    }
};
struct ProbPU {
    static constexpr bool NT_A = false, NT_B = false; static constexpr int EPI_VM = 16; static constexpr bool PERM = true, AFTER_DRAIN = false, ALIGN = true, HAS_MID = false, GATHER = false; static constexpr int NSEG = 1; static constexpr unsigned lda0 = 512u, lda1 = 512u, ldb0 = 512u, ldb1 = 512u;
    int nt, ksw, mid_kt; eng::StaticOrder S; unsigned char* ws;
    __device__ __forceinline__ bool next(int i, Unit& u) const { return S.next(i, u); }
    __device__ __forceinline__ void src(const Unit& u, USrc& s) const {
        s.a0 = s.a1 = (const char*)(ws + WS_PB) + (size_t)u.pm * 256 * 512; s.b0 = s.b1 = (const char*)(ws + WS_WPU) + (size_t)u.pn * 256 * 512;
    }
    __device__ __forceinline__ void epi(const Acc& acc, const Unit& u, int wr, int wc, int fr, int fq) const { asm volatile("" : "+v"(fr), "+v"(fq)); const unsigned char* ws_base_ = ws; (void)ws_base_;
        bf16_t* dst = (bf16_t*)(ws + WS_PLEV) + (size_t)(u.pm * 8 + u.pn) * 65536 + fr * 32 + fq * 8;
#pragma unroll
        for (int ai = 0; ai < 2; ++ai)
#pragma unroll
            for (int m = 0; m < 4; ++m)
#pragma unroll
                for (int bj = 0; bj < 2; ++bj) wt16(ws_base_, dst + ((((ai * 2 + wr) * 4 + m) * 4 + wc) * 2 + bj) * 512, pack8(acc[ai][bj][m][0], acc[ai][bj][m][1]));
    }
};

constexpr int CW_TICK = 3200;
__device__ __forceinline__ void p2_elementwise(Frame& F, const Args& args, const int part) {
    const unsigned char* ws_base_ = F.ws;
    DECL_TID;
    LAS float* sb = (LAS float*)F.lds;
    LAS float* seq = sb + 256;
    LAS float* sek = sb + 512;
    LAS float* nl = sb + 1024;
    const float* gpre = WSP(float, WS_GATEPRE);
    const float* conv_w = INP(4); const float* conv_b = INP(5);
    if (part == 0) for (int un = (int)blockIdx.x; un < BATCH * NCH * MH; un += F.G) {
        const int bh = un >> 4, c = un & 15, b = bh >> 2, h = bh & 3, t0 = b * SEQ + c * LC;
        float lf = 0.f, ip = 0.f;
        if (tid < 256) { const float fp = gpre[(size_t)(t0 + tid) * 8 + 4 + h]; ip = gpre[(size_t)(t0 + tid) * 8 + h];
            lf = fminf(fp, 0.f) - log1pf(__expf(-fabsf(fp))); sb[tid] = lf; }
        __syncthreads();
        for (int o = 1; o < 256; o <<= 1) { float a = 0.f; if (tid < 256) { a = sb[tid]; if (tid >= o) a += sb[tid - o]; } __syncthreads(); if (tid < 256) sb[tid] = a; __syncthreads(); }
        if (tid < 256) { const float bl = sb[tid]; seq[tid] = __expf(bl); sek[tid] = __expf(ip - bl); if (tid == 255) wt4f(ws_base_, WSP(float, WS_GC) + bh * NCH + c, bl); }
        __syncthreads();
        for (int pass = 0; pass < 4; ++pass) {
            const bool isk = pass >= 2; const int blk = (pass & 1) * 512 + tid, ds = blk & 31, rg = blk >> 5, l0 = rg * 8, d0 = ds * 8;
            const int ch = (isk ? MW : 0) + h * DH + d0;
            const bf16_t* src = WSP(bf16_t, isk ? WS_KRAW : WS_QRAW) + (size_t)h * DH + d0;
            float w[4][8], bias[8];
#pragma unroll
            for (int j = 0; j < 4; ++j) { const f32x4 a = *(const GAS f32x4*)(conv_w + (size_t)j * 2048 + ch), bq = *(const GAS f32x4*)(conv_w + (size_t)j * 2048 + ch + 4);
                w[j][0] = a[0]; w[j][1] = a[1]; w[j][2] = a[2]; w[j][3] = a[3]; w[j][4] = bq[0]; w[j][5] = bq[1]; w[j][6] = bq[2]; w[j][7] = bq[3]; }
            { const f32x4 a = *(const GAS f32x4*)(conv_b + ch), bq = *(const GAS f32x4*)(conv_b + ch + 4); bias[0] = a[0]; bias[1] = a[1]; bias[2] = a[2]; bias[3] = a[3]; bias[4] = bq[0]; bias[5] = bq[1]; bias[6] = bq[2]; bias[7] = bq[3]; }
            u32x4 raw[11];
#pragma unroll
            for (int i = 0; i < 11; ++i) { const int l = l0 - 3 + i; const bool ok = (c > 0) || (l >= 0);
                raw[i] = ok ? __builtin_nontemporal_load((const GAS u32x4*)(src + (size_t)(t0 + l) * MW)) : (u32x4){0u, 0u, 0u, 0u}; }
            float val[8][8];
#pragma unroll
            for (int r = 0; r < 8; ++r) {
                float y[8];
#pragma unroll
                for (int d = 0; d < 8; ++d) y[d] = bias[d];
#pragma unroll
                for (int j = 0; j < 4; ++j) { const u32x4 x = raw[r + j];
                    y[0] += w[j][0] * bflo(x.x); y[1] += w[j][1] * bfhi(x.x); y[2] += w[j][2] * bflo(x.y); y[3] += w[j][3] * bfhi(x.y);
                    y[4] += w[j][4] * bflo(x.z); y[5] += w[j][5] * bfhi(x.z); y[6] += w[j][6] * bflo(x.w); y[7] += w[j][7] * bfhi(x.w); }
                const float sc = isk ? sek[l0 + r] * 0.0625f : seq[l0 + r];
#pragma unroll
                for (int d = 0; d < 8; ++d) val[r][d] = fsilu(y[d]) * sc;
            }
            bf16_t* dn = WSP(bf16_t, isk ? WS_KS : WS_QS) + (size_t)(bh * NCH + c) * 65536 + d0;
#pragma unroll
            for (int r = 0; r < 8; ++r) { u32x4 o; o.x = cvt_pk_bf16(val[r][0], val[r][1]); o.y = cvt_pk_bf16(val[r][2], val[r][3]); o.z = cvt_pk_bf16(val[r][4], val[r][5]); o.w = cvt_pk_bf16(val[r][6], val[r][7]);
                wt16(ws_base_, dn + (size_t)(l0 + r) * 256, o); }
            if (isk) {
                bf16_t* dt = WSP(bf16_t, WS_KST) + (size_t)(bh * NCH + c) * 65536 + (size_t)d0 * 256 + l0;
#pragma unroll
                for (int d = 0; d < 8; ++d) { u32x4 o; o.x = cvt_pk_bf16(val[0][d], val[1][d]); o.y = cvt_pk_bf16(val[2][d], val[3][d]); o.z = cvt_pk_bf16(val[4][d], val[5][d]); o.w = cvt_pk_bf16(val[6][d], val[7][d]);
                    wt16(ws_base_, dt + (size_t)d * 256, o); }
#pragma unroll
                for (int d = 0; d < 8; ++d) { float s = 0.f;
#pragma unroll
                    for (int r = 0; r < 8; ++r) s += val[r][d];
                    nl[rg * 256 + d0 + d] = s; }
            }
        }
        __syncthreads();
        if (tid < 256) { float s = 0.f;
#pragma unroll 8
            for (int rg = 0; rg < 32; ++rg) s += nl[rg * 256 + tid];
            wt4f(ws_base_, WSP(float, WS_NLOC) + (size_t)(bh * NCH + c) * 256 + tid, s); }
        __syncthreads();
    }
    LAS float* rs = (LAS float*)F.lds;
    LAS float* rq = rs + 4096;
    LAS float* smu = rq + 4096;
    LAS float* srs = smu + 64;
    const float* ln_g = INP(8); const float* ln_b = INP(9);
    if (part == 1) for (;;) {
        if (tid == 0) F.MISC[16] = __hip_atomic_fetch_add((unsigned*)(F.ctl + CW_TICK), 1u, RLX_AGENT);
        __syncthreads();
        const int un = (int)F.MISC[16];
        if (un >= M / 64) break;
        const int ts = tid & 7, cg = tid >> 3, tk = un * 64 + ts * 8;
        const bf16_t* src = WSP(bf16_t, WS_VGT) + (size_t)(cg * 16) * M + tk;
        u32x4 raw[16]; float s[8], q[8];
#pragma unroll
        for (int d = 0; d < 8; ++d) { s[d] = 0.f; q[d] = 0.f; }
#pragma unroll
        for (int i = 0; i < 16; ++i) { raw[i] = __builtin_nontemporal_load((const GAS u32x4*)(src + (size_t)i * M));
            const float v0 = bflo(raw[i].x), v1 = bfhi(raw[i].x), v2 = bflo(raw[i].y), v3 = bfhi(raw[i].y), v4 = bflo(raw[i].z), v5 = bfhi(raw[i].z), v6 = bflo(raw[i].w), v7 = bfhi(raw[i].w);
            s[0] += v0; s[1] += v1; s[2] += v2; s[3] += v3; s[4] += v4; s[5] += v5; s[6] += v6; s[7] += v7;
            q[0] += v0 * v0; q[1] += v1 * v1; q[2] += v2 * v2; q[3] += v3 * v3; q[4] += v4 * v4; q[5] += v5 * v5; q[6] += v6 * v6; q[7] += v7 * v7; }
#pragma unroll
        for (int d = 0; d < 8; ++d) { rs[cg * 64 + ts * 8 + d] = s[d]; rq[cg * 64 + ts * 8 + d] = q[d]; }
        __syncthreads();
        if (tid < 64) { float a = 0.f, bq = 0.f;
#pragma unroll 8
            for (int g = 0; g < 64; ++g) { a += rs[g * 64 + tid]; bq += rq[g * 64 + tid]; }
            const float mu = a * (1.0f / GW), var = fmaxf(bq * (1.0f / GW) - mu * mu, 0.f); smu[tid] = mu; srs[tid] = 1.0f / sqrtf(var + EPS); }
        __syncthreads();
        float mu[8], rr[8];
#pragma unroll
        for (int d = 0; d < 8; ++d) { mu[d] = smu[ts * 8 + d]; rr[d] = srs[ts * 8 + d]; }
        const int chunk = tk >> 7, s0 = tk & 127;
#pragma unroll
        for (int i = 0; i < 16; ++i) { const int ch = cg * 16 + i; const float g = ln_g[ch], bb = ln_b[ch];
            const float v0 = (bflo(raw[i].x) - mu[0]) * rr[0] * g + bb, v1 = (bfhi(raw[i].x) - mu[1]) * rr[1] * g + bb, v2 = (bflo(raw[i].y) - mu[2]) * rr[2] * g + bb, v3 = (bfhi(raw[i].y) - mu[3]) * rr[3] * g + bb;
            const float v4 = (bflo(raw[i].z) - mu[4]) * rr[4] * g + bb, v5 = (bfhi(raw[i].z) - mu[5]) * rr[5] * g + bb, v6 = (bflo(raw[i].w) - mu[6]) * rr[6] * g + bb, v7 = (bfhi(raw[i].w) - mu[7]) * rr[7] * g + bb;
            u32x4 o; o.x = cvt_pk_bf16(v0, v1); o.y = cvt_pk_bf16(v2, v3); o.z = cvt_pk_bf16(v4, v5); o.w = cvt_pk_bf16(v6, v7);
            const int gp = ch >> 8, gj = (ch >> 7) & 1, e = ch & 127;
            wt16(ws_base_, WSP(bf16_t, WS_VNT) + ((((size_t)gp * 128 + chunk) * 128 + e) * 2 + gj) * 128 + s0, o); }
        __syncthreads();
    }
}

struct ProbP3 {
    static constexpr bool NT_A = false, NT_B = false; static constexpr int EPI_VM = 16; static constexpr bool PERM = true, AFTER_DRAIN = false, ALIGN = true, HAS_MID = false, GATHER = false; static constexpr int NSEG = 1; static constexpr unsigned lda0 = 512u, lda1 = 512u, ldb0 = 512u, ldb1 = 512u;
    int nt, ksw, mid_kt; int G, c0, mode; unsigned char* ws; const float* b_s;
    __device__ __forceinline__ bool next(int i, Unit& u) const { u.pn = 0;
        if (mode == 0) { const int sub = (i >> 1) * G + c0; if (sub >= 256) return false; u.ex = i & 1; u.pm = sub; return true; }
        const int sub = i * G + c0; if (sub >= 256) return false; u.ex = 2; u.pm = sub; return true; }
    __device__ __forceinline__ void src(const Unit& u, USrc& s) const {
        const size_t blk = (size_t)u.pm * 65536 * 2;
        if (u.ex == 0) { s.a0 = (const char*)(ws + WS_QS) + blk; s.b0 = (const char*)(ws + WS_KS) + blk; }
        else if (u.ex == 1) { s.a0 = (const char*)(ws + WS_VT) + blk; s.b0 = (const char*)(ws + WS_KST) + blk; }
        else { const int gp = u.pm >> 6, cp = u.pm & 63; s.a0 = (const char*)(ws + WS_WSBLK) + (size_t)gp * 256 * 512; s.b0 = (const char*)(ws + WS_VNT) + ((size_t)gp * 16384 + cp * 256) * 512; }
        s.a1 = s.a0; s.b1 = s.b0;
    }
    __device__ __forceinline__ void epi_s(const Acc& acc, const Unit& u, int wr, int wc, int fr, int fq) const { const unsigned char* ws_base_ = ws;
        const int bh = u.pm >> 4, ch = u.pm & 15, b = bh >> 2, h = bh & 3; bf16_t* Pd = (bf16_t*)(ws + WS_P) + ((size_t)bh * SEQ + ch * LC) * 256; float* dp = (float*)(ws + WS_DENPART);
#pragma unroll
        for (int ai = 0; ai < 2; ++ai)
#pragma unroll
            for (int m = 0; m < 4; ++m) { const int l = ai * 128 + wr * 64 + m * 16 + fr; float rsum = 0.f;
#pragma unroll
                for (int bj = 0; bj < 2; ++bj) { const int s0 = bj * 128 + wc * 32 + 8 * fq; f32x4 v0 = acc[ai][bj][m][0], v1 = acc[ai][bj][m][1];
                    const float dl = (float)(l - s0 + 1);
#pragma unroll
                    for (int e = 0; e < 4; ++e) { v0[e] *= __builtin_amdgcn_fmed3f(dl - (float)e, 0.f, 1.f); v1[e] *= __builtin_amdgcn_fmed3f(dl - (float)(4 + e), 0.f, 1.f); }
                    rsum += (v0[0] + v0[1]) + (v0[2] + v0[3]) + (v1[0] + v1[1]) + (v1[2] + v1[3]);
                    wt16(ws_base_, Pd + (size_t)l * 256 + s0, pack8(v0, v1)); }
                rsum += __shfl_xor(rsum, 16); rsum += __shfl_xor(rsum, 32);
                if (fq == 0) wt4f(ws_base_, dp + ((size_t)(b * SEQ + ch * LC + l) * 4 + h) * 4 + wc, rsum); }
    }
    __device__ __forceinline__ void epi_kv(const Acc& acc, const Unit& u, int wr, int wc, int fr, int fq) const { const unsigned char* ws_base_ = ws;
        bf16_t* dst = (bf16_t*)(ws + WS_KVT) + (size_t)u.pm * 65536;
#pragma unroll
        for (int ai = 0; ai < 2; ++ai)
#pragma unroll
            for (int m = 0; m < 4; ++m) { bf16_t* rowp = dst + (size_t)(ai * 128 + wr * 64 + m * 16 + fr) * 256 + wc * 32 + 8 * fq;
#pragma unroll
                for (int bj = 0; bj < 2; ++bj) wt16(ws_base_, rowp + bj * 128, pack8(acc[ai][bj][m][0], acc[ai][bj][m][1])); }
    }
    __device__ __forceinline__ void epi_gm(const Acc& acc, const Unit& u, int wr, int wc, int fr, int fq) const { const unsigned char* ws_base_ = ws;
        const int gpi = u.pm >> 6, cp = u.pm & 63; const bf16_t* gu = (const bf16_t*)(ws + WS_GU); bf16_t* hg = (bf16_t*)(ws + WS_HG);
        u32x4 uu[2][4][2]; float bs[2][4];
#pragma unroll
        for (int ai = 0; ai < 2; ++ai) { const int g = 2 * gpi + ai;
#pragma unroll
            for (int m = 0; m < 4; ++m) { const int t = wr * 64 + m * 16 + fr; bs[ai][m] = b_s[g * 128 + t];
#pragma unroll
                for (int bj = 0; bj < 2; ++bj) uu[ai][m][bj] = __builtin_nontemporal_load((const GAS u32x4*)(gu + (size_t)((cp * 2 + bj) * 128 + t) * GW + g * 128 + wc * 32 + 8 * fq)); } }
#pragma unroll
        for (int ai = 0; ai < 2; ++ai) { const int g = 2 * gpi + ai;
#pragma unroll
            for (int m = 0; m < 4; ++m) { const int t = wr * 64 + m * 16 + fr;
#pragma unroll
                for (int bj = 0; bj < 2; ++bj) { const size_t o = (size_t)((cp * 2 + bj) * 128 + t) * GW + g * 128 + wc * 32 + 8 * fq; const u32x4 x = uu[ai][m][bj];
                    f32x4 v0 = acc[ai][bj][m][0] + bs[ai][m], v1 = acc[ai][bj][m][1] + bs[ai][m];
                    v0[0] *= bflo(x.x); v0[1] *= bfhi(x.x); v0[2] *= bflo(x.y); v0[3] *= bfhi(x.y); v1[0] *= bflo(x.z); v1[1] *= bfhi(x.z); v1[2] *= bflo(x.w); v1[3] *= bfhi(x.w);
                    wt16(ws_base_, hg + o, pack8(v0, v1)); } } }
    }
    __device__ __forceinline__ void epi(const Acc& acc, const Unit& u, int wr, int wc, int fr, int fq) const { asm volatile("" : "+v"(fr), "+v"(fq));
        if (u.ex == 0) epi_s(acc, u, wr, wc, fr, fq); else if (u.ex == 1) epi_kv(acc, u, wr, wc, fr, fq); else epi_gm(acc, u, wr, wc, fr, fq);
    }
};

__device__ __forceinline__ void p4_scan(Frame& F) {
    const unsigned char* ws_base_ = F.ws;
    DECL_TID;
    const float* gc = WSP(float, WS_GC);
    { const bf16_t* kv = WSP(const bf16_t, WS_KVT); bf16_t* cp = WSP(bf16_t, WS_CPT);
      for (;;) {
          if (tid == 0) F.MISC[17] = __hip_atomic_fetch_add((unsigned*)(F.ctl + CW_TICK + 64), 1u, RLX_AGENT);
          __syncthreads();
          const int wi = (int)F.MISC[17];
          __syncthreads();
          if (wi >= 16 * 65536 / 8 / NTHR) break;
          const int it = wi * NTHR + tid; { const int bh = it >> 13, ed = (it & 8191) * 8;
          u32x4 kq[NCH - 1]; float eg[NCH - 1];
#pragma unroll
          for (int c = 0; c < NCH - 1; ++c) { const size_t o = (size_t)(bh * NCH + c) * 65536 + ed; kq[c] = __builtin_nontemporal_load((const GAS u32x4*)(kv + o)); eg[c] = __expf(gc[bh * NCH + c]); }
          f32x4 C0 = (f32x4){0.f, 0.f, 0.f, 0.f}, C1 = C0;
#pragma unroll
          for (int c = 0; c < NCH; ++c) { const size_t o = (size_t)(bh * NCH + c) * 65536 + ed;
              wt16(ws_base_, cp + o, pack8(C0, C1));
              if (c < NCH - 1) { const u32x4 q = kq[c]; const f32x4 k0 = (f32x4){bflo(q.x), bfhi(q.x), bflo(q.y), bfhi(q.y)}, k1 = (f32x4){bflo(q.z), bfhi(q.z), bflo(q.w), bfhi(q.w)}; C0 = (C0 + k0) * eg[c]; C1 = (C1 + k1) * eg[c]; } } } } }
    { LAS float* np = (LAS float*)F.lds;
      const float* nloc = WSP(float, WS_NLOC); const bf16_t* qs = WSP(const bf16_t, WS_QS); float* di = WSP(float, WS_DENINTER);
      for (;;) {
          if (tid == 0) F.MISC[18] = __hip_atomic_fetch_add((unsigned*)(F.ctl + CW_TICK + 128), 1u, RLX_AGENT);
          __syncthreads();
          const int un = (int)F.MISC[18];
          if (un >= BATCH * NCH * 4) break;
          const int b = un >> 6, c = (un >> 2) & 15, qt = un & 3;
          for (int i = tid; i < 1024; i += NTHR) { const int h = i >> 8, d = i & 255, bh = b * MH + h; float nl[NCH - 1], eg[NCH - 1];
#pragma unroll
              for (int cc = 0; cc < NCH - 1; ++cc) { const bool ok = cc < c; nl[cc] = ok ? nloc[(size_t)(bh * NCH + cc) * 256 + d] : 0.f; eg[cc] = ok ? __expf(gc[bh * NCH + cc]) : 1.f; }
              float n = 0.f;
#pragma unroll
              for (int cc = 0; cc < NCH - 1; ++cc) n = (n + nl[cc]) * eg[cc];
              np[i] = n; }
          __syncthreads();
          u32x4 qa[8], qb[8];
#pragma unroll
          for (int r = 0; r < 8; ++r) { const int l = qt * 64 + F.wave * 8 + r; const bf16_t* qp = qs + ((size_t)((b * MH + (lane >> 4)) * NCH + c) * 256 + l) * 256 + (lane & 15) * 16; qa[r] = *(const GAS u32x4*)qp; qb[r] = *(const GAS u32x4*)(qp + 8); }
          const LAS float* w = np + lane * 16;
#pragma unroll
          for (int r = 0; r < 8; ++r) { const int t = b * SEQ + c * LC + qt * 64 + F.wave * 8 + r; const u32x4 a = qa[r], bq = qb[r];
              float s = bflo(a.x) * w[0] + bfhi(a.x) * w[1] + bflo(a.y) * w[2] + bfhi(a.y) * w[3] + bflo(a.z) * w[4] + bfhi(a.z) * w[5] + bflo(a.w) * w[6] + bfhi(a.w) * w[7]
                      + bflo(bq.x) * w[8] + bfhi(bq.x) * w[9] + bflo(bq.y) * w[10] + bfhi(bq.y) * w[11] + bflo(bq.z) * w[12] + bfhi(bq.z) * w[13] + bflo(bq.w) * w[14] + bfhi(bq.w) * w[15];
              s += __shfl_xor(s, 1); s += __shfl_xor(s, 2); s += __shfl_xor(s, 4); s += __shfl_xor(s, 8);
              if ((lane & 15) == 0) wt4f(ws_base_, di + (size_t)t * 4 + (lane >> 4), s); }
          __syncthreads(); } }
}

struct ProbO {
    static constexpr bool NT_A = true, NT_B = true; static constexpr int EPI_VM = 0; static constexpr bool PERM = true, AFTER_DRAIN = true, ALIGN = false, HAS_MID = false, GATHER = false; static constexpr int NSEG = 2; static constexpr unsigned lda0 = 512u, lda1 = 512u, ldb0 = 512u, ldb1 = 512u;
    int nt, ksw, mid_kt; int idx; unsigned char* ws; const float* gn_m;
    __device__ __forceinline__ bool next(int i, Unit& u) const { if (i > 0) return false; u.pm = idx >> 4; u.pn = idx & 15; u.ex = 0; return true; }
    __device__ __forceinline__ void src(const Unit& u, USrc& s) const {
        const int b = u.pm >> 2, h = u.pm & 3;
        s.a0 = (const char*)(ws + WS_P) + ((size_t)u.pm * SEQ + u.pn * LC) * 512;
        s.a1 = (const char*)(ws + WS_QS) + (size_t)(u.pm * NCH + u.pn) * 65536 * 2;
        s.b0 = (const char*)(ws + WS_VT) + (size_t)(u.pm * NCH + u.pn) * 65536 * 2;
        s.b1 = (const char*)(ws + WS_CPT) + (size_t)(u.pm * NCH + u.pn) * 65536 * 2;
    }
    __device__ __forceinline__ void fused(Acc& acc, const Unit& u, int wr, int wc, int fr, int fq, LAS unsigned char* lds, int wid, int lane) const { asm volatile("" : "+v"(fr), "+v"(fq)); const unsigned char* ws_base_ = ws; (void)ws_base_;
        const int b = u.pm >> 2, h = u.pm & 3, t0 = b * SEQ + u.pn * LC;
        const float* dp = (const float*)(ws + WS_DENPART); const float* di = (const float*)(ws + WS_DENINTER);
        LAS f32x2* Pst = (LAS f32x2*)lds;
        { f32x4 d4[2][4]; float dv[2][4];
#pragma unroll
          for (int ai = 0; ai < 2; ++ai)
#pragma unroll
            for (int m = 0; m < 4; ++m) { const size_t to = (size_t)(t0 + ai * 128 + wr * 64 + m * 16 + fr) * 4 + h; d4[ai][m] = *(const GAS f32x4*)(dp + to * 4); dv[ai][m] = di[to]; }
#pragma unroll
          for (int ai = 0; ai < 2; ++ai)
#pragma unroll
            for (int m = 0; m < 4; ++m) { const int l = ai * 128 + wr * 64 + m * 16 + fr;
                const float den = ((d4[ai][m][0] + d4[ai][m][1]) + (d4[ai][m][2] + d4[ai][m][3])) + dv[ai][m];
                const float rd = 1.0f / fmaxf(fabsf(den), 1.0f); float s = 0.f, q = 0.f;
#pragma unroll
                for (int bj = 0; bj < 2; ++bj)
#pragma unroll
                    for (int n = 0; n < 2; ++n) { f32x4 v = acc[ai][bj][m][n] * rd; acc[ai][bj][m][n] = v; s += (v[0] + v[1]) + (v[2] + v[3]); q += (v[0] * v[0] + v[1] * v[1]) + (v[2] * v[2] + v[3] * v[3]); }
                s += __shfl_xor(s, 16); s += __shfl_xor(s, 32); q += __shfl_xor(q, 16); q += __shfl_xor(q, 32);
                if (fq == 0) Pst[l * 4 + wc] = (f32x2){s, q}; } }
        asm volatile("s_waitcnt lgkmcnt(0)" ::: "memory"); __builtin_amdgcn_s_barrier(); asm volatile("" ::: "memory");
        const bf16_t* so = (const bf16_t*)(ws + WS_SO); bf16_t* hm = (bf16_t*)(ws + WS_HM);
        f32x4 gn[2][2];
#pragma unroll
        for (int bj = 0; bj < 2; ++bj) { const float* gp_ = gn_m + h * DH + bj * 128 + wc * 32 + 8 * fq; gn[bj][0] = *(const GAS f32x4*)gp_; gn[bj][1] = *(const GAS f32x4*)(gp_ + 4); }
        u32x4 gs[2][4][2];
#pragma unroll
        for (int ai = 0; ai < 2; ++ai)
#pragma unroll
            for (int m = 0; m < 4; ++m)
#pragma unroll
                for (int bj = 0; bj < 2; ++bj) gs[ai][m][bj] = __builtin_nontemporal_load((const GAS u32x4*)(so + (size_t)(t0 + ai * 128 + wr * 64 + m * 16 + fr) * MW + h * DH + bj * 128 + wc * 32 + 8 * fq));
#pragma unroll
        for (int ai = 0; ai < 2; ++ai) {
#pragma unroll
            for (int m = 0; m < 4; ++m) { const int l = ai * 128 + wr * 64 + m * 16 + fr;
                const f32x2 p0 = Pst[l * 4 + 0], p1 = Pst[l * 4 + 1], p2 = Pst[l * 4 + 2], p3 = Pst[l * 4 + 3];
                const float mu = ((p0.x + p1.x) + (p2.x + p3.x)) * (1.0f / 256.0f), var = fmaxf(((p0.y + p1.y) + (p2.y + p3.y)) * (1.0f / 256.0f) - mu * mu, 0.f), rstd = 1.0f / sqrtf(var + EPS);
#pragma unroll
                for (int bj = 0; bj < 2; ++bj) { const size_t o = (size_t)(t0 + l) * MW + h * DH + bj * 128 + wc * 32 + 8 * fq; const u32x4 g = gs[ai][m][bj];
                    f32x4 v0 = (acc[ai][bj][m][0] - mu) * rstd * gn[bj][0], v1 = (acc[ai][bj][m][1] - mu) * rstd * gn[bj][1];
                    v0[0] *= bflo(g.x); v0[1] *= bfhi(g.x); v0[2] *= bflo(g.y); v0[3] *= bfhi(g.y); v1[0] *= bflo(g.z); v1[1] *= bfhi(g.z); v1[2] *= bflo(g.w); v1[3] *= bfhi(g.w);
                    wt16(ws_base_, hm + o, pack8(v0, v1)); } }
            asm volatile("" ::: "memory"); }
        asm volatile("s_waitcnt lgkmcnt(0)" ::: "memory"); __builtin_amdgcn_s_barrier(); asm volatile("" ::: "memory");
    }
    __device__ __forceinline__ void epi(const Acc&, const Unit&, int, int, int, int) const {}
};

struct ProbG23 {
    static constexpr bool NT_A = false, NT_B = false; static constexpr int EPI_VM = 16; static constexpr bool PERM = true, AFTER_DRAIN = false, ALIGN = true, HAS_MID = true, GATHER = false; static constexpr int NSEG = 2; static constexpr unsigned lda0 = 2048u, lda1 = 2048u, ldb0 = 4096u, ldb1 = 4096u;
    int nt, ksw, mid_kt; eng::StaticOrder S; unsigned char* ws;
    __device__ __forceinline__ bool next(int i, Unit& u) const { return S.next(i, u); }
    __device__ __forceinline__ void src(const Unit& u, USrc& s) const {
        s.a0 = (const char*)(ws + WS_HM) + (size_t)u.pm * 256 * 2048; s.a1 = (const char*)(ws + WS_HG) + (size_t)u.pm * 256 * 2048;
        s.b0 = (const char*)(ws + WS_WB) + (size_t)u.pn * 256 * 4096; s.b1 = s.b0 + 2048;
    }
    __device__ __forceinline__ void mid(Acc& acc, u32x2 (&keep)[2][4][2], const Unit& u, int wr, int wc, int fr, int fq) const { asm volatile("" : "+v"(fr), "+v"(fq)); const unsigned char* ws_base_ = ws; (void)ws_base_;
        const unsigned char* gmt = ws + WS_GATES + (size_t)(u.pm * 16 + u.pn) * 65536; const unsigned char* ggt = gmt + (size_t)8 * 65536;
        const bool odd = (fq & 1) != 0; const int lofs = (odd ? 512 : 0) + fr * 32 + (fq & ~1) * 8;
#define U8F(w, j) ((float)(((w) >> (8 * (j))) & 0xffu))
        u32x4 gmLL[2][4], ggLL[2][4];
#pragma unroll
        for (int ai = 0; ai < 2; ++ai)
#pragma unroll
            for (int m = 0; m < 4; ++m) { const int q = ((ai * 2 + wr) * 4 + m) * 4 + wc; gmLL[ai][m] = __builtin_nontemporal_load((const GAS u32x4*)(gmt + q * 1024 + lofs)); ggLL[ai][m] = __builtin_nontemporal_load((const GAS u32x4*)(ggt + q * 1024 + lofs)); }
#pragma unroll
        for (int ai = 0; ai < 2; ++ai) { u32x4 gmL[4], ggL[4];
#pragma unroll
            for (int m = 0; m < 4; ++m) { gmL[m] = gmLL[ai][m]; ggL[m] = ggLL[ai][m]; }
            u32x2 gm[4][2], gg[4][2];
#pragma unroll
            for (int m = 0; m < 4; ++m) {
                { const u32x4 L = gmL[m]; const unsigned sx = odd ? L.x : L.z, sy = odd ? L.y : L.w; const unsigned px = (unsigned)__shfl_xor((int)sx, 16), py = (unsigned)__shfl_xor((int)sy, 16);
                  if (!odd) { gm[m][0] = (u32x2){L.x, L.y}; gm[m][1] = (u32x2){px, py}; } else { gm[m][0] = (u32x2){px, py}; gm[m][1] = (u32x2){L.z, L.w}; } }
                { const u32x4 L = ggL[m]; const unsigned sx = odd ? L.x : L.z, sy = odd ? L.y : L.w; const unsigned px = (unsigned)__shfl_xor((int)sx, 16), py = (unsigned)__shfl_xor((int)sy, 16);
                  if (!odd) { gg[m][0] = (u32x2){L.x, L.y}; gg[m][1] = (u32x2){px, py}; } else { gg[m][0] = (u32x2){px, py}; gg[m][1] = (u32x2){L.z, L.w}; } } }
#pragma unroll
            for (int m = 0; m < 4; ++m)
#pragma unroll
                for (int bj = 0; bj < 2; ++bj) { const u32x2 a = gm[m][bj], c = gg[m][bj]; f32x4 r0, r1;
                    r0[0] = U8F(a.x, 0) * __builtin_amdgcn_rcpf(U8F(c.x, 0)); r0[1] = U8F(a.x, 1) * __builtin_amdgcn_rcpf(U8F(c.x, 1));
                    r0[2] = U8F(a.x, 2) * __builtin_amdgcn_rcpf(U8F(c.x, 2)); r0[3] = U8F(a.x, 3) * __builtin_amdgcn_rcpf(U8F(c.x, 3));
                    r1[0] = U8F(a.y, 0) * __builtin_amdgcn_rcpf(U8F(c.y, 0)); r1[1] = U8F(a.y, 1) * __builtin_amdgcn_rcpf(U8F(c.y, 1));
                    r1[2] = U8F(a.y, 2) * __builtin_amdgcn_rcpf(U8F(c.y, 2)); r1[3] = U8F(a.y, 3) * __builtin_amdgcn_rcpf(U8F(c.y, 3));
                    acc[ai][bj][m][0] *= r0; acc[ai][bj][m][1] *= r1; keep[ai][m][bj] = c; }
            asm volatile("" ::: "memory"); }
    }
    __device__ __forceinline__ void epi(const Acc&, const Unit&, int, int, int, int) const {}
    __device__ __forceinline__ void epi_keep(const Acc& acc, const u32x2 (&gg)[2][4][2], const Unit& u, int wr, int wc, int fr, int fq) const { asm volatile("" : "+v"(fr), "+v"(fq)); const unsigned char* ws_base_ = ws; (void)ws_base_;
        bf16_t* mg = (bf16_t*)(ws + WS_MERGED);
        constexpr float I255 = 1.0f / 255.0f;
#pragma unroll
        for (int ai = 0; ai < 2; ++ai) {
#pragma unroll
            for (int m = 0; m < 4; ++m) { const int row = u.pm * 256 + ai * 128 + wr * 64 + m * 16 + fr; const int col = u.pn * 256 + wc * 32 + 8 * fq;
#pragma unroll
                for (int bj = 0; bj < 2; ++bj) { const u32x2 c = gg[ai][m][bj]; f32x4 v0 = acc[ai][bj][m][0], v1 = acc[ai][bj][m][1];
                    v0[0] *= U8F(c.x, 0) * I255; v0[1] *= U8F(c.x, 1) * I255; v0[2] *= U8F(c.x, 2) * I255; v0[3] *= U8F(c.x, 3) * I255;
                    v1[0] *= U8F(c.y, 0) * I255; v1[1] *= U8F(c.y, 1) * I255; v1[2] *= U8F(c.y, 2) * I255; v1[3] *= U8F(c.y, 3) * I255;
                    wt16(ws_base_, mg + (size_t)row * D + col + bj * 128, pack8(v0, v1)); } }
            asm volatile("" ::: "memory"); }
    }
#undef U8F
};

struct ProbG4 {
    static constexpr bool NT_A = false, NT_B = false; static constexpr int EPI_VM = 16; static constexpr bool PERM = true, AFTER_DRAIN = false, ALIGN = true, HAS_MID = false, GATHER = false; static constexpr int NSEG = 1; static constexpr unsigned lda0 = 4096u, lda1 = 4096u, ldb0 = 4096u, ldb1 = 4096u;
    int nt, ksw, mid_kt; eng::StaticOrder S; unsigned char* ws;
    __device__ __forceinline__ bool next(int i, Unit& u) const { return S.next(i, u); }
    __device__ __forceinline__ void src(const Unit& u, USrc& s) const {
        s.a0 = s.a1 = (const char*)(ws + WS_MERGED) + (size_t)u.pm * 256 * 4096; s.b0 = s.b1 = (const char*)(ws + WS_WOUT) + (size_t)u.pn * 256 * 4096;
    }
    __device__ __forceinline__ void epi(const Acc& acc, const Unit& u, int wr, int wc, int fr, int fq) const { asm volatile("" : "+v"(fr), "+v"(fq)); const unsigned char* ws_base_ = ws; (void)ws_base_;
        bf16_t* dst = (bf16_t*)(ws + WS_MIX);
        const int row0 = u.pm * 256 + wr * 64 + fr, col0 = u.pn * 256 + wc * 32 + 8 * fq;
#pragma unroll
        for (int ai = 0; ai < 2; ++ai)
#pragma unroll
            for (int m = 0; m < 4; ++m) { bf16_t* rowp = dst + (size_t)(row0 + ai * 128 + m * 16) * D + col0;
#pragma unroll
                for (int bj = 0; bj < 2; ++bj) wt16(ws_base_, rowp + bj * 128, pack8(acc[ai][bj][m][0], acc[ai][bj][m][1])); }
    }
};

__device__ __forceinline__ void p8_router(Frame& F, const Args& args) {
    const unsigned char* ws_base_ = F.ws;
    DECL_TID;
    const float* g_ffn = INP(15);
    { LAS float* scr = (LAS float*)(F.lds + F.wave * TSCR_BYTES);
      const int gw = F.vcu * NWAVES + F.wave, NGW = F.G * NWAVES;
      constexpr int I_13 = 32 * 32 * 16, I_2 = 32 * 8 * 32;
      const int sl = lane & 15, grp2 = sl >> 3, isw3 = (sl >> 2) & 1, c4 = (sl & 3) * 4;
      for (int rep2 = 0; rep2 < (((REPEAT_MASK >> 14) & 1) ? 2 : 1); ++rep2)
      for (int it = gw; it < W13_STATIC_ITEMS; it += NGW) {
          if (it < I_13) { const int e = it >> 9, r = it & 511, kb = r & 31, nb = r >> 5;
              const float* wsrc = isw3 ? INP(21) : INP(20);
              transpose_item(F.ws, wsrc + (size_t)e * D * DE + (nb * 2 + grp2) * 16 + c4, DE, g_ffn, kb * 64, WSP(bf16_t, WS_W13) + ((size_t)e * 1024 + nb * 64) * D + kb * 64, D, scr, lane); }
          else { const int r2 = it - I_13, e = r2 >> 8, r = r2 & 255, kb = r & 7, nb = r >> 3;
              transpose_item(F.ws, INP(22) + (size_t)e * DE * D + nb * 64 + (lane & 15) * 4, D, nullptr, kb * 64, WSP(bf16_t, WS_W2) + ((size_t)e * D + nb * 64) * DE + kb * 64, DE, scr, lane); }
      } }
    __syncthreads();
    LAS bf16_t* we = (LAS bf16_t*)F.lds;
    { const float* w_re = INP(18);
      for (int idx = tid; idx < D * 32 / 2; idx += NTHR) { const int k = idx >> 4, e2 = (idx & 15) * 2; const float g = g_ffn[k];
          const f32x2 w = *(const GAS f32x2*)(w_re + (size_t)k * 32 + e2); we[e2 * D + k] = (bf16_t)f2bf(w.x * g); we[(e2 + 1) * D + k] = (bf16_t)f2bf(w.y * g); } }
    LAS int* s_e = (LAS int*)(F.lds + XTR_OFF);
    LAS float* s_w = (LAS float*)(F.lds + XTR_OFF + 512);
    LAS int* s_cnt = (LAS int*)(F.lds + XTR_OFF + 1024);
    LAS int* s_base = s_cnt + 32;
    LAS int* s_rank = s_cnt + 64;
    LAS bf16_t* wgl = (LAS bf16_t*)(F.lds + XTR_OFF + 4096);
    { const float* w_rg = INP(16);
      for (int k = tid; k < D; k += NTHR) { const f32x4 w = *(const GAS f32x4*)(w_rg + (size_t)k * 4); const float g = g_ffn[k];
          wgl[0 * D + k] = (bf16_t)f2bf(w[0] * g); wgl[1 * D + k] = (bf16_t)f2bf(w[1] * g); wgl[2 * D + k] = (bf16_t)f2bf(w[2] * g); wgl[3 * D + k] = (bf16_t)f2bf(w[3] * g); } }
    const float* b_rg = INP(17); const float* b_re = INP(19);
    const float* xin = INP(0); const bf16_t* mix = WSP(const bf16_t, WS_MIX); bf16_t* x1b = WSP(bf16_t, WS_X1B);
    for (int blk = F.vcu; blk < M / 64; blk += F.G) {
        if (tid < 32) s_cnt[tid] = 0;
        __syncthreads();
        f32x4 nx[8]; u32x4 nm[4];
        { const int t = blk * 64 + F.wave * 8; const float* xrow = xin + (size_t)t * D; const bf16_t* mrow = mix + (size_t)t * D;
#pragma unroll
          for (int p = 0; p < 4; ++p) { nm[p] = __builtin_nontemporal_load((const GAS u32x4*)(mrow + 512 * p + 8 * lane)); nx[2 * p] = __builtin_nontemporal_load((const GAS f32x4*)(xrow + E0(2 * p))); nx[2 * p + 1] = __builtin_nontemporal_load((const GAS f32x4*)(xrow + E0(2 * p + 1))); } }
#pragma unroll 1
        for (int r = 0; r < 8; ++r) { const int tl = F.wave * 8 + r, t = blk * 64 + tl;
            bf16_t* xbrow = x1b + (size_t)t * D;
            f32x4 v[8]; float ss = 0.f, g0 = 0.f, g1 = 0.f, g2 = 0.f, g3 = 0.f;
#pragma unroll
            for (int p = 0; p < 4; ++p) { const u32x4 mm = nm[p]; f32x4 a = nx[2 * p], b = nx[2 * p + 1];
                a[0] += bflo(mm.x); a[1] += bfhi(mm.x); a[2] += bflo(mm.y); a[3] += bfhi(mm.y); b[0] += bflo(mm.z); b[1] += bfhi(mm.z); b[2] += bflo(mm.w); b[3] += bfhi(mm.w);
                v[2 * p] = a; v[2 * p + 1] = b; }
            if (r < 7) { const float* xrow = xin + (size_t)(t + 1) * D; const bf16_t* mrow = mix + (size_t)(t + 1) * D;
#pragma unroll
                for (int p = 0; p < 4; ++p) { nm[p] = __builtin_nontemporal_load((const GAS u32x4*)(mrow + 512 * p + 8 * lane)); nx[2 * p] = __builtin_nontemporal_load((const GAS f32x4*)(xrow + E0(2 * p))); nx[2 * p + 1] = __builtin_nontemporal_load((const GAS f32x4*)(xrow + E0(2 * p + 1))); } }
#pragma unroll
            for (int j = 0; j < 8; ++j) ss += (v[j][0] * v[j][0] + v[j][1] * v[j][1]) + (v[j][2] * v[j][2] + v[j][3] * v[j][3]);
            float gacc[4];
#pragma unroll
            for (int g = 0; g < 4; ++g) { const LAS bf16_t* wp = wgl + g * D + 8 * lane; float a = 0.f;
#pragma unroll
                for (int p = 0; p < 4; ++p) { const u32x4 w = *(const LAS u32x4*)(wp + 512 * p); a += ((v[2 * p][0] * bflo(w.x) + v[2 * p][1] * bfhi(w.x)) + (v[2 * p][2] * bflo(w.y) + v[2 * p][3] * bfhi(w.y))) + ((v[2 * p + 1][0] * bflo(w.z) + v[2 * p + 1][1] * bfhi(w.z)) + (v[2 * p + 1][2] * bflo(w.w) + v[2 * p + 1][3] * bfhi(w.w))); }
                gacc[g] = a; }
            g0 = gacc[0]; g1 = gacc[1]; g2 = gacc[2]; g3 = gacc[3];
            ss = wave_sum(ss); g0 = wave_sum(g0); g1 = wave_sum(g1); g2 = wave_sum(g2); g3 = wave_sum(g3);
            const float rr = 1.0f / sqrtf(ss * (1.0f / D) + EPS);
#pragma unroll
            for (int p = 0; p < 4; ++p) wt16(ws_base_, xbrow + 512 * p + 8 * lane, pack8(v[2 * p] * rr, v[2 * p + 1] * rr));
            float gl[4] = {rr * g0 + b_rg[0], rr * g1 + b_rg[1], rr * g2 + b_rg[2], rr * g3 + b_rg[3]};
            int grp = 0; float gmax = gl[0];
#pragma unroll
            for (int g = 1; g < 4; ++g) if (gl[g] > gmax) { gmax = gl[g]; grp = g; }
            const float pg = 1.0f / ((__expf(gl[0] - gmax) + __expf(gl[1] - gmax)) + (__expf(gl[2] - gmax) + __expf(gl[3] - gmax)));
            float el[8];
#pragma unroll
            for (int e = 0; e < 8; ++e) { const LAS bf16_t* wp = we + (size_t)(grp * 8 + e) * D + 8 * lane; float a = 0.f;
#pragma unroll
                for (int p = 0; p < 4; ++p) { const u32x4 w = *(const LAS u32x4*)(wp + 512 * p); a += ((v[2 * p][0] * bflo(w.x) + v[2 * p][1] * bfhi(w.x)) + (v[2 * p][2] * bflo(w.y) + v[2 * p][3] * bfhi(w.y))) + ((v[2 * p + 1][0] * bflo(w.z) + v[2 * p + 1][1] * bfhi(w.z)) + (v[2 * p + 1][2] * bflo(w.w) + v[2 * p + 1][3] * bfhi(w.w))); }
                el[e] = rr * wave_sum(a) + b_re[grp * 8 + e]; }
            int i0 = 0; float m0 = el[0];
#pragma unroll
            for (int e = 1; e < 8; ++e) if (el[e] > m0) { m0 = el[e]; i0 = e; }
            int i1 = -1; float m1 = -3.0e38f;
#pragma unroll
            for (int e = 0; e < 8; ++e) if (e != i0 && el[e] > m1) { m1 = el[e]; i1 = e; }
            const float e1 = __expf(m1 - m0), w0 = pg / (1.0f + e1), w1 = pg * e1 / (1.0f + e1);
            if (lane == 0) { s_e[tl * 2] = grp * 8 + i0; s_e[tl * 2 + 1] = grp * 8 + i1; s_w[tl * 2] = w0; s_w[tl * 2 + 1] = w1; wt4f(ws_base_, WSP(float, WS_R1) + t, rr); }
        }
        __syncthreads();
        if (tid < 128) s_rank[tid] = atomicAdd((int*)&s_cnt[s_e[tid]], 1);
        __syncthreads();
        { const int t2 = F.wave * 64 + lane_id();
          if (t2 < 32) { const int c = s_cnt[t2]; s_base[t2] = c > 0 ? (int)__hip_atomic_fetch_add((unsigned*)(F.ctl + CW_CNT + 64 * t2), (unsigned)c, RLX_AGENT) : 0; } }
        __syncthreads();
        if (tid < 128) { const int e = s_e[tid], pos = s_base[e] + s_rank[tid]; wt4(ws_base_, WSP(int, WS_LIST) + (size_t)e * M + pos, (unsigned)((blk * 64 + (tid >> 1)) * 2 + (tid & 1))); wt4f(ws_base_, WSP(float, WS_LISTW) + (size_t)e * M + pos, s_w[tid]); }
        __syncthreads();
    }
}

__device__ __forceinline__ void moe_table(Frame& F, LAS int* tstart, LAS int* cnt) {
    DECL_TID;
    if (tid < 32) cnt[tid] = (int)__hip_atomic_load((unsigned*)(F.ctl + CW_CNT + 64 * tid), RLX_AGENT);
    __syncthreads();
    if (tid == 0) { int a = 0; for (int e = 0; e < 32; ++e) { tstart[e] = a; a += (cnt[e] + 255) >> 8; } tstart[32] = a; }
    __syncthreads();
}
__device__ __forceinline__ int moe_expert_of(const LAS int* tstart, int rt) { int e = 0; while (e < 31 && tstart[e + 1] <= rt) ++e; return e; }

struct ProbMU {
    static constexpr bool NT_A = false, NT_B = false; static constexpr int EPI_VM = 8; static constexpr bool PERM = false, AFTER_DRAIN = false, ALIGN = true, HAS_MID = false, GATHER = true; static constexpr int NSEG = 1; static constexpr unsigned lda0 = 4096u, lda1 = 4096u, ldb0 = 4096u, ldb1 = 4096u;
    int nt, ksw, mid_kt; int G, c0, nun; unsigned char* ws; const LAS int* tstart; const LAS int* cnt;
    __device__ __forceinline__ bool next(int i, Unit& u) const { const int idx = i * G + c0; if (idx >= nun) return false;
        u.pm = idx >> 2; u.pn = idx & 3; u.ex = __builtin_amdgcn_readfirstlane(moe_expert_of(tstart, u.pm)); return true; }
    __device__ __forceinline__ void src(const Unit& u, USrc& s) const {
        s.a0 = s.a1 = (const char*)(ws + WS_X1B);
        s.b0 = s.b1 = (const char*)(ws + WS_W13) + ((size_t)u.ex * 1024 + u.pn * 256) * 4096;
    }
    __device__ __forceinline__ int tok_of(const Unit& u, int r) const { const int pos = (u.pm - __builtin_amdgcn_readfirstlane(tstart[u.ex])) * 256 + r;
        return pos < __builtin_amdgcn_readfirstlane(cnt[u.ex]) ? (((const int*)(ws + WS_LIST))[(size_t)u.ex * M + pos] >> 1) : 0; }
    __device__ __forceinline__ unsigned arow(const Unit& u, int r) const { return (unsigned)tok_of(u, r) * 4096u; }
    __device__ __forceinline__ void epi(const Acc& acc, const Unit& u, int wr, int wc, int fr, int fq) const { asm volatile("" : "+v"(fr), "+v"(fq)); const unsigned char* ws_base_ = ws; (void)ws_base_;
        bf16_t* H = (bf16_t*)(ws + WS_H);
#pragma unroll
        for (int ai = 0; ai < 2; ++ai)
#pragma unroll
            for (int m = 0; m < 4; ++m) { const int r = ai * 128 + wr * 64 + m * 16 + fr;
                u32x2 w0, w1;
                { const f32x4 a = acc[ai][0][m][0], bq = acc[ai][0][m][1]; w0.x = cvt_pk_bf16(fsilu(a[0]) * bq[0], fsilu(a[1]) * bq[1]); w0.y = cvt_pk_bf16(fsilu(a[2]) * bq[2], fsilu(a[3]) * bq[3]); }
                { const f32x4 a = acc[ai][1][m][0], bq = acc[ai][1][m][1]; w1.x = cvt_pk_bf16(fsilu(a[0]) * bq[0], fsilu(a[1]) * bq[1]); w1.y = cvt_pk_bf16(fsilu(a[2]) * bq[2], fsilu(a[3]) * bq[3]); }
                const bool odd = (fq & 1) != 0;
                const unsigned sx = odd ? w0.x : w1.x, sy = odd ? w0.y : w1.y;
                const unsigned px = (unsigned)__shfl_xor((int)sx, 16), py = (unsigned)__shfl_xor((int)sy, 16);
                u32x4 o; if (!odd) { o.x = w0.x; o.y = w0.y; o.z = px; o.w = py; } else { o.x = px; o.y = py; o.z = w1.x; o.w = w1.y; }
                bf16_t* rowp = H + (size_t)(u.pm * 256 + r) * DE + u.pn * 128 + wc * 16 + 4 * (fq & ~1) + (odd ? 64 : 0);
                wt16(ws_base_, rowp, o); if (m & 1) asm volatile("" ::: "memory"); }
    }
};
struct ProbMD {
    static constexpr bool NT_A = false, NT_B = false; static constexpr int EPI_VM = 16; static constexpr bool PERM = true, AFTER_DRAIN = false, ALIGN = true, HAS_MID = false, GATHER = false; static constexpr int NSEG = 1; static constexpr unsigned lda0 = 1024u, lda1 = 1024u, ldb0 = 1024u, ldb1 = 1024u;
    int nt, ksw, mid_kt; int G, c0; unsigned char* ws; const LAS int* tstart; const LAS int* cnt;
    __device__ __forceinline__ bool next(int i, Unit& u) const { const int idx = i * G + c0; if (idx >= __builtin_amdgcn_readfirstlane(tstart[32]) * 8) return false;
        const int rt = idx >> 3; u.pm = rt; u.pn = idx & 7; u.ex = __builtin_amdgcn_readfirstlane(moe_expert_of(tstart, rt)); return true; }
    __device__ __forceinline__ void src(const Unit& u, USrc& s) const {
        s.a0 = s.a1 = (const char*)(ws + WS_H) + (size_t)u.pm * 256 * 1024;
        s.b0 = s.b1 = (const char*)(ws + WS_W2) + ((size_t)u.ex * D + u.pn * 256) * 1024;
    }
    __device__ __forceinline__ void epi(const Acc& acc, const Unit& u, int wr, int wc, int fr, int fq) const { asm volatile("" : "+v"(fr), "+v"(fq)); const unsigned char* ws_base_ = ws; (void)ws_base_;
        bf16_t* Y = (bf16_t*)(ws + WS_Y); const int* list = (const int*)(ws + WS_LIST); const float* lw = (const float*)(ws + WS_LISTW);
        const int j = u.pm - __builtin_amdgcn_readfirstlane(tstart[u.ex]), n = __builtin_amdgcn_readfirstlane(cnt[u.ex]);
        int t2[2][4]; float wv[2][4];
#pragma unroll
        for (int ai = 0; ai < 2; ++ai)
#pragma unroll
            for (int m = 0; m < 4; ++m) { const int pos = j * 256 + ai * 128 + wr * 64 + m * 16 + fr; const bool ok = pos < n;
                t2[ai][m] = ok ? list[(size_t)u.ex * M + pos] : -1; wv[ai][m] = ok ? lw[(size_t)u.ex * M + pos] : 0.f; }
#pragma unroll
        for (int ai = 0; ai < 2; ++ai)
#pragma unroll
            for (int m = 0; m < 4; ++m) {
                const bool ok = t2[ai][m] >= 0; const float w = wv[ai][m];
                bf16_t* rowp = ok ? Y + (size_t)t2[ai][m] * D + u.pn * 256 + wc * 32 + 8 * fq : (bf16_t*)(ws + WS_DUMP) + ((wr * 4 + wc) * 64 + fq * 16 + fr) * 8;
                const int bjs = ok ? 128 : 4096;
#pragma unroll
                for (int bj = 0; bj < 2; ++bj) wt16(ws_base_, rowp + bj * bjs, pack8(acc[ai][bj][m][0] * w, acc[ai][bj][m][1] * w)); }
    }
};

__device__ __forceinline__ void p11_combine(Frame& F) {
    const unsigned char* ws_base_ = F.ws;
    DECL_TID; const int gw = F.vcu * NWAVES + F.wave, NGW = F.G * NWAVES;
    const bf16_t* Y = WSP(const bf16_t, WS_Y); bf16_t* xb = WSP(bf16_t, WS_X1B); float* r2 = WSP(float, WS_R2); const float* r1 = WSP(const float, WS_R1);
    for (int m = gw; m < M; m += NGW) { const float q = 1.0f / r1[m];
        const bf16_t* y0 = Y + (size_t)(2 * m) * D + 8 * lane; const bf16_t* y1 = Y + (size_t)(2 * m + 1) * D + 8 * lane; bf16_t* ob = xb + (size_t)m * D + 8 * lane;
        float ss = 0.f;
#pragma unroll
        for (int p = 0; p < 4; ++p) { const u32x4 x = __builtin_nontemporal_load((const GAS u32x4*)(ob + 512 * p)), a = __builtin_nontemporal_load((const GAS u32x4*)(y0 + 512 * p)), b = __builtin_nontemporal_load((const GAS u32x4*)(y1 + 512 * p)); f32x4 v0, v1;
            v0[0] = bflo(x.x) * q + (bflo(a.x) + bflo(b.x)); v0[1] = bfhi(x.x) * q + (bfhi(a.x) + bfhi(b.x)); v0[2] = bflo(x.y) * q + (bflo(a.y) + bflo(b.y)); v0[3] = bfhi(x.y) * q + (bfhi(a.y) + bfhi(b.y));
            v1[0] = bflo(x.z) * q + (bflo(a.z) + bflo(b.z)); v1[1] = bfhi(x.z) * q + (bfhi(a.z) + bfhi(b.z)); v1[2] = bflo(x.w) * q + (bflo(a.w) + bflo(b.w)); v1[3] = bfhi(x.w) * q + (bfhi(a.w) + bfhi(b.w));
            wt16(ws_base_, ob + 512 * p, pack8(v0, v1));
            ss += ((v0[0] * v0[0] + v0[1] * v0[1]) + (v0[2] * v0[2] + v0[3] * v0[3])) + ((v1[0] * v1[0] + v1[1] * v1[1]) + (v1[2] * v1[2] + v1[3] * v1[3])); }
        ss = wave_sum(ss);
        if (lane == 0) wt4f(ws_base_, r2 + m, 1.0f / sqrtf(ss * (1.0f / D) + EPS));
    }
}

struct ProbPG {
    static constexpr bool NT_A = false, NT_B = false; static constexpr int EPI_VM = 16; static constexpr bool PERM = true, AFTER_DRAIN = false, ALIGN = true, HAS_MID = false, GATHER = false; static constexpr int NSEG = 1; static constexpr unsigned lda0 = 4096u, lda1 = 4096u, ldb0 = 4096u, ldb1 = 4096u;
    int nt, ksw, mid_kt; eng::StaticOrder S; unsigned char* ws;
    __device__ __forceinline__ bool next(int i, Unit& u) const { return S.next(i, u); }
    __device__ __forceinline__ void src(const Unit& u, USrc& s) const {
        s.a0 = s.a1 = (const char*)(ws + WS_X1B) + (size_t)u.pm * 256 * 4096; s.b0 = s.b1 = (const char*)(ws + WS_WPG) + (size_t)u.pn * 256 * 4096;
    }
    __device__ __forceinline__ void epi(const Acc& acc, const Unit& u, int wr, int wc, int fr, int fq) const { asm volatile("" : "+v"(fr), "+v"(fq)); const unsigned char* ws_base_ = ws; (void)ws_base_;
        const float* r2 = (const float*)(ws + WS_R2); const bf16_t* ple = (const bf16_t*)(ws + WS_PLEV) + (size_t)(u.pm * 8 + u.pn) * 65536 + fr * 32 + fq * 8; bf16_t* gp = (bf16_t*)(ws + WS_GP);
        u32x4 pv[2][4][2]; float rs[2][4];
#pragma unroll
        for (int ai = 0; ai < 2; ++ai)
#pragma unroll
            for (int m = 0; m < 4; ++m) { const int row = u.pm * 256 + ai * 128 + wr * 64 + m * 16 + fr; rs[ai][m] = r2[row];
#pragma unroll
                for (int bj = 0; bj < 2; ++bj) pv[ai][m][bj] = __builtin_nontemporal_load((const GAS u32x4*)(ple + ((((ai * 2 + wr) * 4 + m) * 4 + wc) * 2 + bj) * 512)); }
#pragma unroll
        for (int ai = 0; ai < 2; ++ai) {
#pragma unroll
            for (int m = 0; m < 4; ++m) { const size_t ro = (size_t)(u.pm * 256 + ai * 128 + wr * 64 + m * 16 + fr) * D + u.pn * 256 + wc * 32 + 8 * fq;
#pragma unroll
                for (int bj = 0; bj < 2; ++bj) { const u32x4 p = pv[ai][m][bj]; f32x4 v0 = act4<1>(acc[ai][bj][m][0] * rs[ai][m]), v1 = act4<1>(acc[ai][bj][m][1] * rs[ai][m]);
                    v0[0] *= bflo(p.x); v0[1] *= bfhi(p.x); v0[2] *= bflo(p.y); v0[3] *= bfhi(p.y); v1[0] *= bflo(p.z); v1[1] *= bfhi(p.z); v1[2] *= bflo(p.w); v1[3] *= bfhi(p.w);
                    wt16(ws_base_, gp + ro + bj * 128, pack8(v0, v1)); } }
            asm volatile("" ::: "memory"); }
    }
};

__device__ __forceinline__ void p13_final(Frame& F, const Args& args) {
    DECL_TID; const int gw = F.vcu * NWAVES + F.wave, NGW = F.G * NWAVES;
    const bf16_t* gp = WSP(const bf16_t, WS_GP); const float* gf = INP(26);
    f32x4 g[8];
#pragma unroll
    for (int j = 0; j < 8; ++j) g[j] = *(const GAS f32x4*)(gf + E0(j));
    for (int m = gw; m < M; m += NGW) {
        float* orow = F.out + (size_t)m * D; const bf16_t* pr = gp + (size_t)m * D + 8 * lane; const bf16_t* xq = WSP(const bf16_t, WS_X1B) + (size_t)m * D + 8 * lane;
        f32x4 v[8]; float ss = 0.f;
#pragma unroll
        for (int p = 0; p < 4; ++p) { const u32x4 a = __builtin_nontemporal_load((const GAS u32x4*)(pr + 512 * p)), x = __builtin_nontemporal_load((const GAS u32x4*)(xq + 512 * p));
            v[2 * p][0] = bflo(x.x) + bflo(a.x); v[2 * p][1] = bfhi(x.x) + bfhi(a.x); v[2 * p][2] = bflo(x.y) + bflo(a.y); v[2 * p][3] = bfhi(x.y) + bfhi(a.y);
            v[2 * p + 1][0] = bflo(x.z) + bflo(a.z); v[2 * p + 1][1] = bfhi(x.z) + bfhi(a.z); v[2 * p + 1][2] = bflo(x.w) + bflo(a.w); v[2 * p + 1][3] = bfhi(x.w) + bfhi(a.w); }
#pragma unroll
        for (int j = 0; j < 8; ++j) ss += (v[j][0] * v[j][0] + v[j][1] * v[j][1]) + (v[j][2] * v[j][2] + v[j][3] * v[j][3]);
        ss = wave_sum(ss);
        const float r = 1.0f / sqrtf(ss * (1.0f / D) + EPS);
#pragma unroll
        for (int j = 0; j < 8; ++j) __builtin_nontemporal_store(v[j] * r * g[j], (GAS f32x4*)(orow + E0(j)));
    }
}

__device__ __forceinline__ void conv_tickets(Frame& F, const Args& args, const int set) {
    DECL_TID; LAS float* scr = (LAS float*)(F.lds + F.wave * TSCR_BYTES);
    const int nb_tot = set == 0 ? 256 : 128, ns4 = (lane & 15) * 4;
    for (;;) {
        if (tid == 0) F.MISC[21] = __hip_atomic_fetch_add((unsigned*)(F.ctl + CW_TICK + 256 + 64 * set), 1u, RLX_AGENT);
        __syncthreads();
        const int bt = (int)F.MISC[21];
        __syncthreads();
        if (bt >= nb_tot) break;
        int r = bt * 8 + F.wave;
        if (set == 0) {
            if (r < 512) { const int kb = r / 32, nb = r % 32;
                transpose_item(F.ws, INP(12) + nb * 64 + ns4, D, nullptr, kb * 64, WSP(bf16_t, WS_WB) + (size_t)(nb * 64) * D + kb * 64, D, scr, lane); }
            else if (r < 1024) { r -= 512; const int kb = r / 32, nb = r % 32;
                transpose_item(F.ws, INP(13) + nb * 64 + ns4, D, nullptr, kb * 64, WSP(bf16_t, WS_WB) + (size_t)(nb * 64) * D + MW + kb * 64, D, scr, lane); }
            else { r -= 1024; const int kb = r / 32, nb = r % 32;
                transpose_item(F.ws, INP(14) + nb * 64 + ns4, D, nullptr, kb * 64, WSP(bf16_t, WS_WOUT) + (size_t)(nb * 64) * D + kb * 64, D, scr, lane); }
        } else { const int kb = r / 32, nb = r % 32;
            transpose_item(F.ws, INP(25) + nb * 64 + ns4, D, INP(23), kb * 64, WSP(bf16_t, WS_WPG) + (size_t)(nb * 64) * D + kb * 64, D, scr, lane); }
    }
}

__device__ __forceinline__ void w13_tickets(Frame& F, const Args& args, const int half) {
    DECL_TID; LAS float* scr = (LAS float*)(F.lds + F.wave * TSCR_BYTES);
    const float* g_ffn = INP(15);
    const int sl = lane & 15, grp2 = sl >> 3, isw3 = (sl >> 2) & 1, c4 = (sl & 3) * 4;
    for (;;) {
        if (tid == 0) F.MISC[22] = __hip_atomic_fetch_add((unsigned*)(F.ctl + CW_TICK + 384 + 64 * half), 1u, RLX_AGENT);
        __syncthreads();
        const int bt = (int)F.MISC[22];
        __syncthreads();
        if (bt >= 256) break;
        const int it = W13_STATIC_ITEMS + (half * 256 + bt) * 8 + F.wave, e = it >> 9, r = it & 511, kb = r & 31, nb = r >> 5;
        const float* wsrc = isw3 ? INP(21) : INP(20);
        transpose_item(F.ws, wsrc + (size_t)e * D * DE + (nb * 2 + grp2) * 16 + c4, DE, g_ffn, kb * 64, WSP(bf16_t, WS_W13) + ((size_t)e * 1024 + nb * 64) * D + kb * 64, D, scr, lane);
    }
}

__device__ __forceinline__ void w2_convert_tickets(Frame& F, const Args& args) {
    DECL_TID; LAS float* scr = (LAS float*)(F.lds + F.wave * TSCR_BYTES);
    for (;;) {
        if (tid == 0) F.MISC[20] = __hip_atomic_fetch_add((unsigned*)(F.ctl + CW_TICK + 192), 1u, RLX_AGENT);
        __syncthreads();
        const int bt = (int)F.MISC[20];
        __syncthreads();
        if (bt >= 1024) break;
        const int r2 = bt * 8 + F.wave, e = r2 >> 8, r = r2 & 255, kb = r & 7, nb = r >> 3;
        transpose_item(F.ws, INP(22) + (size_t)e * DE * D + nb * 64 + (lane & 15) * 4, D, nullptr, kb * 64, WSP(bf16_t, WS_W2) + ((size_t)e * D + nb * 64) * DE + kb * 64, DE, scr, lane);
    }
}

__global__ void __launch_bounds__(NTHR, 2) mk_fwd(Args args) {
    extern __shared__ __attribute__((aligned(16))) unsigned char lds[];
    Frame F;
    F.lds = (LAS unsigned char*)lds;
    F.MISC = (volatile LAS unsigned*)(F.lds + MISC_OFF);
    F.wave = __builtin_amdgcn_readfirstlane((int)threadIdx.x >> 6);
    F.G = gridDim.x; { const int bx = blockIdx.x; F.vcu = (F.G % 8 == 0) ? (bx % 8) * (F.G / 8) + bx / 8 : bx; }
    F.ws = args.ws; F.out = args.out; F.ctl = (gu32*)(args.ws + WS_CTL);
    for (int u = (int)threadIdx.x; u < (LDS_BYTES - LDSCTL_OFF) / 4; u += NTHR) ((LAS unsigned*)(F.lds + LDSCTL_OFF))[u] = 0u;
    __syncthreads();
    XcdBarrier bar; bar.bar = (unsigned*)(F.ctl + CW_BAR); bar.x = 0; bar.st = nullptr;
    if (N_LAUNCHES == 1) bar = xcd_barrier_post((unsigned*)(F.ctl + CW_BAR), F.MISC + 8);
    const int lo = args.ph_lo, hi = args.ph_hi;
#define IN(k) (((PHASE_MASK >> (k)) & 1) && lo <= (k) && (k) < hi)
#define SEAM(k) do { if (IN(k) && IN((k) + 1)) xcd_barrier(bar); } while (0)
#define REP(k) for (int rep_ = 0; rep_ < (((REPEAT_MASK >> (k)) & 1) ? 2 : 1); ++rep_)
    LAS unsigned char* ring = F.lds;
    const int bx = (int)blockIdx.x;

    REP(0) if (IN(0)) { if (rep_) xcd_barrier(bar); p0_prologue(F, args); } SEAM(0);
    REP(1) if (IN(1)) { if (rep_) xcd_barrier(bar);
        { ProbG1 P; P.nt = 32; P.ksw = 1 << 20; P.mid_kt = -1; P.S.init(M, NG1, F.G, bx); P.ws = F.ws; eng::gemm_phase(ring, P, F.wave); }
        { ProbPU P; P.nt = 4; P.ksw = 1 << 20; P.mid_kt = -1; P.S.init(M, D, F.G, bx); P.ws = F.ws; eng::gemm_phase(ring, P, F.wave); }
    } SEAM(1);
    REP(2) if (IN(2)) { if (rep_) xcd_barrier(bar); p2_elementwise(F, args, 0);
        asm volatile("s_waitcnt vmcnt(0)" ::: "memory"); __syncthreads();
        if (threadIdx.x == 0) { __builtin_amdgcn_fence(__ATOMIC_ACQUIRE, "agent"); asm volatile("s_waitcnt vmcnt(0)" ::: "memory"); }
        __syncthreads();
        { ProbP3 P; P.nt = 4; P.ksw = 1 << 20; P.mid_kt = -1; P.G = F.G; P.c0 = bx; P.mode = 0; P.ws = F.ws; P.b_s = INP(11); eng::gemm_phase(ring, P, F.wave); }
        p2_elementwise(F, args, 1);
    } SEAM(2);
    REP(3) if (IN(3)) { if (rep_) xcd_barrier(bar);
        { ProbP3 P; P.nt = 4; P.ksw = 1 << 20; P.mid_kt = -1; P.G = F.G; P.c0 = bx; P.mode = 1; P.ws = F.ws; P.b_s = INP(11); eng::gemm_phase(ring, P, F.wave); }
        p4_scan(F);
    } SEAM(3);
    REP(5) if (IN(5)) { if (rep_) xcd_barrier(bar);
        for (int idx = bx; idx < 256; idx += F.G) { ProbO P; P.nt = 8; P.ksw = 4; P.mid_kt = -1; P.idx = idx; P.ws = F.ws; P.gn_m = INP(7); eng::gemm_phase(ring, P, F.wave); }
        conv_tickets(F, args, 0);
    } SEAM(5);
    REP(6) if (IN(6)) { if (rep_) xcd_barrier(bar); ProbG23 P; P.nt = 32; P.ksw = 16; P.mid_kt = 16; P.S.init(M, D, F.G, bx); P.ws = F.ws; eng::gemm_phase(ring, P, F.wave); w13_tickets(F, args, 0); } SEAM(6);
    REP(7) if (IN(7)) { if (rep_) xcd_barrier(bar); ProbG4 P; P.nt = 32; P.ksw = 1 << 20; P.mid_kt = -1; P.S.init(M, D, F.G, bx); P.ws = F.ws; eng::gemm_phase(ring, P, F.wave); w13_tickets(F, args, 1); } SEAM(7);
    REP(8) if (IN(8)) { if (rep_) xcd_barrier(bar); p8_router(F, args); } SEAM(8);
    LAS int* tstart = (LAS int*)(F.lds + XTR_OFF + 2048); LAS int* tcnt = tstart + 64;
    REP(9) if (IN(9)) { if (rep_) xcd_barrier(bar);
        moe_table(F, tstart, tcnt);
        const int nun = __builtin_amdgcn_readfirstlane(tstart[32]) * 4;
        { ProbMU P; P.nt = 32; P.ksw = 1 << 20; P.mid_kt = -1; P.G = F.G; P.c0 = bx; P.nun = nun; P.ws = F.ws; P.tstart = tstart; P.cnt = tcnt; eng::gemm_phase(ring, P, F.wave); }
        w2_convert_tickets(F, args);
        conv_tickets(F, args, 1);
    } SEAM(9);
    REP(10) if (IN(10)) { if (rep_) xcd_barrier(bar);
        moe_table(F, tstart, tcnt);
        ProbMD P; P.nt = 8; P.ksw = 1 << 20; P.mid_kt = -1; P.G = F.G; P.c0 = bx; P.ws = F.ws; P.tstart = tstart; P.cnt = tcnt; eng::gemm_phase(ring, P, F.wave);
    } SEAM(10);
    REP(11) if (IN(11)) { if (rep_) xcd_barrier(bar); p11_combine(F); } SEAM(11);
    REP(12) if (IN(12)) { if (rep_) xcd_barrier(bar); ProbPG P; P.nt = 32; P.ksw = 1 << 20; P.mid_kt = -1; P.S.init(M, D, F.G, bx); P.ws = F.ws; eng::gemm_phase(ring, P, F.wave); } SEAM(12);
    REP(13) if (IN(13)) { if (rep_) xcd_barrier(bar); p13_final(F, args); }
#undef IN
#undef SEAM
}

extern "C" void kernel_launch(void* const* d_in, const int* in_sizes, int n_in, void* d_out, int out_size, void* d_ws, size_t ws_size, hipStream_t stream) {
    static int grid = 0;
    if (grid == 0) {
        if (n_in != 27 || out_size != M * D || ws_size < WS_END) { fprintf(stderr, "kernel_launch: unexpected problem (n_in %d, out %d, ws %zu < %zu)\n", n_in, out_size, ws_size, (size_t)WS_END); grid = -1; return; }
        int dev = 0, cus = 0, per_cu = 0;
        if (hipGetDevice(&dev) != hipSuccess || hipDeviceGetAttribute(&cus, hipDeviceAttributeMultiprocessorCount, dev) != hipSuccess) { grid = -1; return; }
        if (hipFuncSetAttribute((const void*)mk_fwd, hipFuncAttributeMaxDynamicSharedMemorySize, LDS_BYTES) != hipSuccess) { fprintf(stderr, "kernel_launch: hipFuncSetAttribute failed\n"); grid = -1; return; }
        if (hipOccupancyMaxActiveBlocksPerMultiprocessor(&per_cu, (const void*)mk_fwd, NTHR, LDS_BYTES) != hipSuccess || per_cu < 1) fprintf(stderr, "kernel_launch: occupancy query reports %d\n", per_cu);
        (void)hipGetLastError();
        grid = cus;
    }
    if (grid < 0) return;
    (void)hipMemsetAsync((char*)d_ws + WS_CTL, 0, CTL_ZERO_BYTES, stream);
    Args a{};
    for (int i = 0; i < 27; ++i) a.in[i] = (const float*)d_in[i];
    a.out = (float*)d_out; a.ws = (unsigned char*)d_ws;
    if (N_LAUNCHES == 1) { a.ph_lo = 0; a.ph_hi = NPHASE; hipLaunchKernelGGL(mk_fwd, dim3(grid), dim3(NTHR), LDS_BYTES, stream, a); }
    else { for (int p = 0; p < NPHASE; ++p) { a.ph_lo = p; a.ph_hi = p + 1; hipLaunchKernelGGL(mk_fwd, dim3(grid), dim3(NTHR), LDS_BYTES, stream, a); } }
}
```
